# Optimizing an MI355X kernel written in HIP

```python
import jax, jax.numpy as jnp
from jax import lax
import numpy as np

D_MODEL = 1024
BATCH = 4
SEQ = 8192
DEPTH = 2

D_MIX = 1024
DA_HEADS = 4
DA_HEAD_DIM = 64
DA_V_DIM = 2 * DA_HEAD_DIM
DA_QK = DA_HEADS * 2 * DA_HEAD_DIM
DA_WIDTH = DA_HEADS * DA_V_DIM
HG_HEADS = 4
HG_K_DIM = 128
HG_V_DIM = 128
HG_K = HG_HEADS * HG_K_DIM
HG_WIDTH = HG_HEADS * HG_V_DIM
IN_SIZES = (DA_QK, DA_QK, DA_WIDTH, HG_K, HG_K, HG_K, HG_WIDTH, HG_WIDTH)
D_IN = DA_QK * 2 + DA_WIDTH + HG_K * 3 + HG_WIDTH * 2
D_FF = 2816
CONV_WIDTH = 3
ROPE_THETA = 10000.0
Q_BLOCK = 128
CHUNK = 64
EPS = 1e-6
EXP_CLAMP = 30.0

kernel_name = "hybrid_diffattn_hgrn2_convglu_encoder"


def rms_norm(x, g):
    xf = x.astype(jnp.float32)
    y = xf * lax.rsqrt(jnp.mean(xf * xf, axis=-1, keepdims=True) + EPS)
    return (y * g.astype(jnp.float32)).astype(x.dtype)


def rope_tables(positions):
    half = DA_HEAD_DIM // 2
    inv_freq = ROPE_THETA ** (-jnp.arange(half, dtype=jnp.float32) / half)
    ang = positions.astype(jnp.float32)[:, None, None, :, None] * inv_freq
    return jnp.cos(ang), jnp.sin(ang)


def apply_rope(t, cos, sin):
    tf = t.astype(jnp.float32)
    t1, t2 = jnp.split(tf, 2, axis=-1)
    return jnp.concatenate([t1 * cos - t2 * sin, t2 * cos + t1 * sin], axis=-1).astype(t.dtype)


def split_cols(p, sizes):
    idx = []
    acc = 0
    for s in sizes[:-1]:
        acc += s
        idx.append(acc)
    return jnp.split(p, idx, axis=-1)


def to_heads(t, n_heads):
    b, s, _ = t.shape
    return t.reshape(b, s, n_heads, -1).transpose(0, 2, 1, 3)


def diff_attention(q, k, v, cos, sin, q_g, k_g, lam, lam_init, out_g):
    b, s, _ = q.shape
    q = rms_norm(q.reshape(b, s, DA_HEADS, 2, DA_HEAD_DIM), q_g)
    k = rms_norm(k.reshape(b, s, DA_HEADS, 2, DA_HEAD_DIM), k_g)
    q = apply_rope(q.transpose(0, 2, 3, 1, 4), cos, sin) * (DA_HEAD_DIM ** -0.5)
    k = apply_rope(k.transpose(0, 2, 3, 1, 4), cos, sin)
    v = to_heads(v, DA_HEADS)
    n_blocks = s // Q_BLOCK
    qb = jnp.moveaxis(q.reshape(b, DA_HEADS, 2, n_blocks, Q_BLOCK, DA_HEAD_DIM), 3, 0)

    def block(qi):
        scores = jnp.einsum('bhcqd,bhckd->bhcqk', qi, k).astype(jnp.float32)
        probs = jax.nn.softmax(scores, axis=-1)
        weights = probs[:, :, 0] - lam * probs[:, :, 1]
        return jnp.einsum('bhqk,bhkv->bhqv', weights.astype(v.dtype), v)

    o = lax.map(block, qb)
    o = o.transpose(1, 0, 3, 2, 4).reshape(b, s, DA_HEADS, DA_V_DIM)
    o = rms_norm(o, out_g) * (1.0 - lam_init)
    return o.reshape(b, s, DA_WIDTH)


def gla_chunk_scan(q, k, v, log_f):
    b, h, s, dk = q.shape
    dv = v.shape[-1]
    n = s // CHUNK

    def chunks(t):
        return jnp.moveaxis(t.reshape(b, h, n, CHUNK, t.shape[-1]), 2, 0)

    qc, kc, vc = chunks(q), chunks(k), chunks(v)
    bc = jnp.cumsum(chunks(log_f), axis=-2)
    mask = jnp.tril(jnp.ones((CHUNK, CHUNK), dtype=bool))[:, :, None]

    def step(state, inp):
        q_, k_, v_, b_ = inp
        diff = b_[:, :, :, None, :] - b_[:, :, None, :, :]
        decay = jnp.where(mask, jnp.exp(jnp.where(mask, diff, 0.0)), 0.0)
        scores = jnp.einsum('bhtd,bhsd,bhtsd->bhts', q_, k_, decay)
        b_last = b_[:, :, -1:, :]
        o = (jnp.einsum('bhts,bhsv->bhtv', scores, v_)
             + jnp.einsum('bhtd,bhdv->bhtv', q_ * jnp.exp(b_), state))
        state = (jnp.exp(b_last)[:, :, 0, :, None] * state
                 + jnp.einsum('bhsd,bhsv->bhdv', k_ * jnp.exp(b_last - b_), v_))
        return state, o

    state0 = jnp.zeros((b, h, dk, dv), jnp.float32)
    _, o = lax.scan(step, state0, (qc, kc, vc, bc))
    return jnp.moveaxis(o, 0, 2).reshape(b, h, s, dv)


def hgrn2_bidirectional(q, z_fwd, z_bwd, inp, gate, lb_fwd, lb_bwd, out_g):
    b, s, _ = q.shape
    qh = to_heads(q, HG_HEADS).astype(jnp.float32)
    ih = to_heads(inp, HG_HEADS).astype(jnp.float32)

    def gates(z, lb):
        zh = to_heads(z, HG_HEADS).astype(jnp.float32)
        lbh = lb.astype(jnp.float32).reshape(HG_HEADS, 1, HG_K_DIM)
        log_f = jax.nn.log_sigmoid(zh) + jnp.log1p(lbh * jnp.exp(jnp.minimum(-zh, EXP_CLAMP)))
        log_f = jnp.minimum(log_f, 0.0)
        key = (1.0 - lbh) * jax.nn.sigmoid(-zh)
        return key, log_f

    k_f, lf_f = gates(z_fwd, lb_fwd)
    k_b, lf_b = gates(z_bwd, lb_bwd)
    o_fwd = gla_chunk_scan(qh, k_f, ih, lf_f)
    flip = lambda t: jnp.flip(t, axis=2)
    o_bwd = flip(gla_chunk_scan(flip(qh), flip(k_b), flip(ih), flip(lf_b)))
    o = (o_fwd + o_bwd).transpose(0, 2, 1, 3).astype(q.dtype)
    g = gate.reshape(b, s, HG_HEADS, HG_V_DIM)
    o = rms_norm(o, out_g) * jax.nn.silu(g)
    return o.reshape(b, s, HG_WIDTH)


def conv_glu_ffn(h, w_up, conv_w, conv_b, w_down):
    u = h @ w_up
    up = jnp.pad(u, ((0, 0), (1, 1), (0, 0)))
    u = conv_w[0] * up[:, :-2] + conv_w[1] * up[:, 1:-1] + conv_w[2] * up[:, 2:] + conv_b
    a, v = jnp.split(u, 2, axis=-1)
    return (jax.nn.silu(a) * v) @ w_down


def setup_inputs(seed: int = 0) -> dict:
    key = jax.random.key(seed)
    ks = jax.random.split(key, 24)
    f32 = jnp.float32
    nrm = lambda k, shape, scale: jax.random.normal(k, shape, f32) * scale
    gain = lambda k, shape: 1.0 + 0.02 * jax.random.normal(k, shape, f32)
    x = jax.random.normal(ks[0], (BATCH, SEQ, D_MODEL), f32)
    offsets = jax.random.randint(ks[1], (BATCH, 1), 0, 1024, dtype=jnp.int32)
    positions = (jnp.arange(SEQ, dtype=jnp.int32)[None, :] + offsets).astype(jnp.int32)
    return {
        "x": x,
        "positions": positions,
        "mix_norm_g": gain(ks[2], (DEPTH, D_MODEL)),
        "w_in": nrm(ks[3], (DEPTH, D_MODEL, D_IN), D_MODEL ** -0.5),
        "q_norm_g": gain(ks[4], (DEPTH, DA_HEAD_DIM)),
        "k_norm_g": gain(ks[5], (DEPTH, DA_HEAD_DIM)),
        "lam_q1": nrm(ks[6], (DEPTH, DA_HEAD_DIM), 0.1),
        "lam_k1": nrm(ks[7], (DEPTH, DA_HEAD_DIM), 0.1),
        "lam_q2": nrm(ks[8], (DEPTH, DA_HEAD_DIM), 0.1),
        "lam_k2": nrm(ks[9], (DEPTH, DA_HEAD_DIM), 0.1),
        "diff_out_g": gain(ks[10], (DEPTH, DA_V_DIM)),
        "hg_lb_logits": nrm(ks[11], (DEPTH, 2, HG_K), 0.5),
        "hg_out_g": gain(ks[12], (DEPTH, HG_V_DIM)),
        "w_out": nrm(ks[13], (DEPTH, D_MIX, D_MODEL), D_MIX ** -0.5),
        "ffn_norm_g": gain(ks[14], (DEPTH, D_MODEL)),
        "w_up": nrm(ks[15], (DEPTH, D_MODEL, 2 * D_FF), D_MODEL ** -0.5),
        "conv_w": nrm(ks[16], (DEPTH, CONV_WIDTH, 2 * D_FF), CONV_WIDTH ** -0.5),
        "conv_b": nrm(ks[17], (DEPTH, 2 * D_FF), 0.02),
        "w_down": nrm(ks[18], (DEPTH, D_FF, D_MODEL), D_FF ** -0.5),
    }


def reference(x, positions, mix_norm_g, w_in, q_norm_g, k_norm_g, lam_q1, lam_k1, lam_q2, lam_k2,
              diff_out_g, hg_lb_logits, hg_out_g, w_out, ffn_norm_g, w_up, conv_w, conv_b, w_down):
    cos, sin = rope_tables(positions)
    p = jax.nn.softmax(hg_lb_logits.astype(jnp.float32), axis=0)
    lower_bounds = jnp.clip(jnp.cumsum(p, axis=0) - p[0:1], 0.0, 1.0 - 1e-4)
    for l in range(DEPTH):
        h = rms_norm(x, mix_norm_g[l])
        proj = h @ w_in[l]
        da_q, da_k, da_v, hg_q, hg_zf, hg_zb, hg_i, hg_g = split_cols(proj, IN_SIZES)
        lam_init = 0.8 - 0.6 * float(np.exp(-0.3 * l))
        lam = (jnp.exp(jnp.sum(lam_q1[l].astype(jnp.float32) * lam_k1[l].astype(jnp.float32)))
               - jnp.exp(jnp.sum(lam_q2[l].astype(jnp.float32) * lam_k2[l].astype(jnp.float32)))
               + lam_init)
        y_a = diff_attention(da_q, da_k, da_v, cos, sin, q_norm_g[l], k_norm_g[l], lam, lam_init, diff_out_g[l])
        y_b = hgrn2_bidirectional(hg_q, hg_zf, hg_zb, hg_i, hg_g,
                                  lower_bounds[l, 0], lower_bounds[l, 1], hg_out_g[l])
        x = x + jnp.concatenate([y_a, y_b.astype(y_a.dtype)], axis=-1) @ w_out[l]
        x = x + conv_glu_ffn(rms_norm(x, ffn_norm_g[l]), w_up[l], conv_w[l], conv_b[l], w_down[l])
    return x
```

```cpp
#include <hip/hip_runtime.h>
#include <hip/hip_cooperative_groups.h>
#include <cstdio>
#include <cstdint>
namespace cg = cooperative_groups;

typedef unsigned short bf16_t;
typedef short bf16x8 __attribute__((ext_vector_type(8)));
typedef short s16x4 __attribute__((ext_vector_type(4)));
typedef float f32x2 __attribute__((ext_vector_type(2)));
typedef float f32x4 __attribute__((ext_vector_type(4)));
typedef float f32x16 __attribute__((ext_vector_type(16)));
typedef unsigned u32x2 __attribute__((ext_vector_type(2)));
typedef unsigned u32x4 __attribute__((ext_vector_type(4)));
typedef __bf16 bfv2 __attribute__((ext_vector_type(2)));

#define DI __device__ __forceinline__

constexpr int T_ = 32768, S_ = 8192, NB = 4, D_ = 1024, DIN = 4096, DFF = 2816, DUP = 5632;
constexpr int NTHREADS = 512, NWAVES = 8;
constexpr int LDS_MAIN = 144 * 1024;
constexpr int LDS_BYTES = LDS_MAIN + 16;
constexpr float EPS = 1e-6f;
constexpr float LOG2E = 1.4426950408889634f, LN2 = 0.6931471805599453f;

constexpr size_t OFF_WIN = 0;
constexpr size_t OFF_WOUT = OFF_WIN + 2ull * 4096 * 1024 * 2;
constexpr size_t OFF_WUP = OFF_WOUT + 2ull * 1024 * 1024 * 2;
constexpr size_t OFF_WDN = OFF_WUP + 2ull * 5632 * 1024 * 2;
constexpr size_t OFF_ROPE = OFF_WDN + 2ull * 1024 * 2816 * 2;
constexpr size_t OFF_MISC = OFF_ROPE + (size_t)T_ * 64 * 4;
constexpr size_t OFF_H = OFF_MISC + 65536;
constexpr size_t OFF_DEC = OFF_H + (size_t)T_ * 1024 * 2;
constexpr size_t OFF_VT = OFF_DEC + 2048ull * 128 * 4;
constexpr size_t OFF_PROJ = OFF_VT + (size_t)T_ * 512 * 2;
constexpr size_t OFF_Y = OFF_PROJ + (size_t)T_ * 4096 * 2;
constexpr size_t OFF_BAR = OFF_Y + (size_t)T_ * 1024 * 2;
constexpr size_t OFF_SSQ = OFF_BAR + 16384;
constexpr size_t WS_END = OFF_SSQ + 3ull * T_ * 16 * 4;
constexpr int CNT_WORD = 3584;
constexpr size_t OFF_ACT = OFF_PROJ;
constexpr size_t OFF_HALO = OFF_Y;

struct Params {
    const float* x; const int* pos; const float* mix_g; const float* w_in; const float* qg; const float* kg;
    const float* lq1; const float* lk1; const float* lq2; const float* lk2; const float* dog; const float* lbl; const float* hog;
    const float* w_out; const float* ffn_g; const float* w_up; const float* conv_w; const float* conv_b; const float* w_down;
    float* out; unsigned char* ws;
};

DI unsigned pk2(float lo, float hi) { f32x2 v = {lo, hi}; bfv2 r = __builtin_convertvector(v, bfv2); return __builtin_bit_cast(unsigned, r); }
DI float bf2f(bf16_t h) { return __uint_as_float((unsigned)h << 16); }
DI float bflo(unsigned u) { return __uint_as_float(u << 16); }
DI float bfhi(unsigned u) { return __uint_as_float(u & 0xffff0000u); }
DI bf16_t f2bf(float f) { return (bf16_t)(pk2(f, 0.f) & 0xffffu); }
DI bf16x8 pack8(float a0, float a1, float a2, float a3, float a4, float a5, float a6, float a7) {
    u32x4 p; p.x = pk2(a0, a1); p.y = pk2(a2, a3); p.z = pk2(a4, a5); p.w = pk2(a6, a7); return __builtin_bit_cast(bf16x8, p);
}
DI int otid() { int t = threadIdx.x; asm volatile("" : "+v"(t)); return t; }
DI float shx(float v, int m) { const int l = otid() & 63; return __builtin_bit_cast(float, __builtin_amdgcn_ds_bpermute((l ^ m) << 2, __builtin_bit_cast(int, v))); }
DI float shl_(float v, int srclane) { return __builtin_bit_cast(float, __builtin_amdgcn_ds_bpermute(srclane << 2, __builtin_bit_cast(int, v))); }
DI float wave_sum(float v) {
#pragma unroll
    for (int o = 1; o < 64; o <<= 1) v += shx(v, o);
    return v;
}
DI float wave_max(float v) {
#pragma unroll
    for (int o = 1; o < 64; o <<= 1) v = fmaxf(v, shx(v, o));
    return v;
}
DI size_t pidx(int g, int b, int h, int s) { return ((size_t)((g * 4 + b) * 4 + h) * S_ + s) * 128; }
DI int obid() { int b = blockIdx.x; asm volatile("" : "+s"(b)); return b; }
DI int ogdim() { int g = gridDim.x; asm volatile("" : "+s"(g)); return g; }
DI float fexp(float x) { return __builtin_amdgcn_exp2f(x * LOG2E); }
DI int crow(int reg, int h) { return (reg & 3) + 8 * (reg >> 2) + 4 * h; }
#define MFMA32(a, b, c) __builtin_amdgcn_mfma_f32_32x32x16_bf16((a), (b), (c), 0, 0, 0)

DI void transpose_load(const float* W, int N, int nblk, int item, float* scr, int lane) {
    const int kb = item / nblk, nb = item % nblk, k0 = 64 * kb, n0 = 64 * nb;
    const int n4 = lane & 15, kq = lane >> 4;
    f32x4 v[16];
#pragma unroll
    for (int i = 0; i < 16; ++i) v[i] = *(const f32x4*)(W + (size_t)(k0 + 4 * i + kq) * N + n0 + 4 * n4);
#pragma unroll
    for (int i = 0; i < 16; ++i) { float* s = scr + (4 * i + kq) * 65 + 4 * n4; s[0] = v[i].x; s[1] = v[i].y; s[2] = v[i].z; s[3] = v[i].w; }
}
DI void transpose_store(bf16_t* WT, int K, int nblk, int item, const float* scr, int lane, bool glu_perm) {
    const int kb = item / nblk, nb = item % nblk, k0 = 64 * kb;
    int n0 = 64 * nb;
    if (glu_perm) n0 = n0 < DFF ? ((n0 >> 7) << 8) + (n0 & 127) : (((n0 - DFF) >> 7) << 8) + 128 + ((n0 - DFF) & 127);
    const int c = lane & 7;
#pragma unroll
    for (int j = 0; j < 8; ++j) {
        const int n = (lane >> 3) + 8 * j; const float* s = scr + (8 * c) * 65 + n;
        u32x4 o; o.x = pk2(s[0], s[65]); o.y = pk2(s[130], s[195]); o.z = pk2(s[260], s[325]); o.w = pk2(s[390], s[455]);
        *(u32x4*)(WT + (size_t)(n0 + n) * K + k0 + 8 * c) = o;
    }
}

DI void phase_prologue(const Params& p, char* shm) {
    const int tid = otid(), wave = tid >> 6, lane = tid & 63;
    float* scr = (float*)shm + wave * (64 * 65);
    constexpr int I_IN = 16 * 64, I_OUT = 16 * 16, I_UP = 16 * 88, I_DN = 44 * 16, I_L = I_IN + I_OUT + I_UP + I_DN, NITEMS = 2 * I_L;
    for (int base = obid() * NWAVES; base < NITEMS; base += ogdim() * NWAVES) {
        const int it = base + wave; const bool act = it < NITEMS;
        const float* W = nullptr; bf16_t* WT = nullptr; int K = 0, N = 0, r = 0;
        if (act) {
            const int l = it / I_L; r = it % I_L;
            if (r < I_IN) { W = p.w_in + (size_t)l * 1024 * 4096; WT = (bf16_t*)(p.ws + OFF_WIN) + (size_t)l * 4096 * 1024; K = 1024; N = 4096; }
            else if ((r -= I_IN) < I_OUT) { W = p.w_out + (size_t)l * 1024 * 1024; WT = (bf16_t*)(p.ws + OFF_WOUT) + (size_t)l * 1024 * 1024; K = 1024; N = 1024; }
            else if ((r -= I_OUT) < I_UP) { W = p.w_up + (size_t)l * 1024 * 5632; WT = (bf16_t*)(p.ws + OFF_WUP) + (size_t)l * 5632 * 1024; K = 1024; N = 5632; }
            else { r -= I_UP; W = p.w_down + (size_t)l * 2816 * 1024; WT = (bf16_t*)(p.ws + OFF_WDN) + (size_t)l * 1024 * 2816; K = 2816; N = 1024; }
            transpose_load(W, N, N / 64, r, scr, lane);
        }
        __syncthreads();
        if (act) transpose_store(WT, K, N / 64, r, scr, lane, N == DUP);
        __syncthreads();
    }
    float* rope = (float*)(p.ws + OFF_ROPE);
    for (int e = obid() * NTHREADS + tid; e < T_ * 32; e += ogdim() * NTHREADS) {
        const int t = e >> 5, i = e & 31;
        const float inv_freq = exp2f(-(float)i * (13.287712379549449f / 32.f));
        const float ang = (float)p.pos[t] * inv_freq;
        double rev = (double)ang * 0.15915494309189535; rev -= rint(rev);
        const float fr = (float)rev;
        rope[(size_t)t * 64 + i] = __builtin_amdgcn_cosf(fr);
        rope[(size_t)t * 64 + 32 + i] = __builtin_amdgcn_sinf(fr);
    }
    if (obid() == 0) {
        float* misc = (float*)(p.ws + OFF_MISC);
        for (int e = tid; e < 1024; e += NTHREADS) {
            const float a0 = p.lbl[e], a1 = p.lbl[1024 + e];
            const float m = fmaxf(a0, a1), e0 = expf(a0 - m), e1 = expf(a1 - m), p0 = e0 / (e0 + e1), p1 = e1 / (e0 + e1);
            const float l0 = p0 - p0, l1 = (p0 + p1) - p0;
            misc[e] = fminf(fmaxf(l0, 0.f), 1.f - 1e-4f);
            misc[1024 + e] = fminf(fmaxf(l1, 0.f), 1.f - 1e-4f);
        }
        if (wave < 2) {
            const int l = wave;
            const float s1 = wave_sum(p.lq1[l * 64 + lane] * p.lk1[l * 64 + lane]);
            const float s2 = wave_sum(p.lq2[l * 64 + lane] * p.lk2[l * 64 + lane]);
            const float mq = wave_max(fabsf(p.qg[l * 64 + lane])), mk = wave_max(fabsf(p.kg[l * 64 + lane]));
            const float lam_init = 0.8f - 0.6f * expf(-0.3f * (float)l);
            if (lane == 0) { misc[2048 + l] = expf(s1) - expf(s2) + lam_init; misc[2050 + l] = 8.f * mq * mk * LOG2E + 0.5f; misc[2052 + l] = 1.f - lam_init; }
        }
    }
}

DI void phase_rmsnorm(const float* __restrict__ x, const float* __restrict__ g, bf16_t* __restrict__ h) {
    const int tid = otid(), wave = tid >> 6, lane = tid & 63;
    f32x4 gv[4];
#pragma unroll
    for (int j = 0; j < 4; ++j) gv[j] = ((const f32x4*)g)[lane + 64 * j];
    for (int row0 = (obid() * NWAVES + wave) * 4; row0 < T_; row0 += ogdim() * NWAVES * 4) {
        f32x4 v[4][4]; float s[4];
#pragma unroll
        for (int rr = 0; rr < 4; ++rr) {
            const f32x4* xr = (const f32x4*)(x + (size_t)(row0 + rr) * D_) + lane;
            s[rr] = 0.f;
#pragma unroll
            for (int j = 0; j < 4; ++j) { v[rr][j] = xr[64 * j]; s[rr] += (v[rr][j].x * v[rr][j].x + v[rr][j].y * v[rr][j].y) + (v[rr][j].z * v[rr][j].z + v[rr][j].w * v[rr][j].w); }
        }
#pragma unroll
        for (int o = 1; o < 64; o <<= 1) {
#pragma unroll
            for (int rr = 0; rr < 4; ++rr) s[rr] += shx(s[rr], o);
        }
#pragma unroll
        for (int rr = 0; rr < 4; ++rr) {
            const float rstd = 1.0f / sqrtf(s[rr] * (1.f / D_) + EPS);
            u32x2* o = (u32x2*)(h + (size_t)(row0 + rr) * D_) + lane;
#pragma unroll
            for (int j = 0; j < 4; ++j) {
                u32x2 w; w.x = pk2(v[rr][j].x * rstd * gv[j].x, v[rr][j].y * rstd * gv[j].y); w.y = pk2(v[rr][j].z * rstd * gv[j].z, v[rr][j].w * rstd * gv[j].w);
                o[64 * j] = w;
            }
        }
    }
}

DI int lds_byte(int r, int c) { const int st = (r >> 4) * 2 + (c >> 5), rr = r & 15, cc = c & 31, ob = rr * 64 + cc * 2; return st * 1024 + (ob ^ (((ob >> 9) & 1) << 5)); }
DI int perm32(int rho) { const int n = rho >> 4, i = rho & 15; return 8 * (i >> 2) + 4 * n + (i & 3); }
DI void stage_rc(int b, int& R, int& C) { const int st = b / 1024, sb = b % 1024, swz = sb ^ (((sb >> 9) & 1) << 5); R = (st >> 1) * 16 + swz / 64; C = (st & 1) * 32 + (swz % 64) / 2; }

DI bool tile_order(int i, int G, int c, int nM, int nN, int& pm, int& pn) {
    const long L = (long)i * G + c; const int nwg = nM * nN; if (L >= nwg) return false;
    int wgid = (int)L; { const int q = nwg / 8, r = nwg % 8, xcd = wgid % 8, off = wgid / 8; wgid = (xcd < r ? xcd * (q + 1) : r * (q + 1) + (xcd - r) * q) + off; }
    const int nig = 8 * nN, gid = wgid / nig, fm = gid * 8, gsz = (nM - fm) < 8 ? (nM - fm) : 8;
    pm = fm + ((wgid % nig) % gsz); pn = (wgid % nig) / gsz; return true;
}

enum { EPI_PROJ = 0, EPI_RESID = 1, EPI_BF16 = 2, EPI_GLU = 3, EPI_RESIDN = 4 };
struct EpiArgs { bf16_t* ob; int ldo; bf16_t* vt; const float* resid; float* of; const float* lb; const float* cw; const float* cb; bf16_t* halo; float* ssqp; unsigned* cnt; const float* gn; bf16_t* hn; };

DI void epi_resid(const f32x4 (&acc)[2][2][4][2], const float* __restrict__ resid, float* __restrict__ of, int brow, int bcol, int wr, int wc, int fr, int fq) {
#pragma unroll
    for (int ai = 0; ai < 2; ++ai)
#pragma unroll
        for (int m = 0; m < 4; ++m) {
            const size_t ro = (size_t)(brow + ai * 128 + wr * 64 + m * 16 + fr) * D_ + bcol + wc * 32 + 8 * fq;
            f32x4 r[2][2];
#pragma unroll
            for (int bj = 0; bj < 2; ++bj)
#pragma unroll
                for (int n = 0; n < 2; ++n) r[bj][n] = *(const f32x4*)(resid + ro + bj * 128 + n * 4);
#pragma unroll
            for (int bj = 0; bj < 2; ++bj)
#pragma unroll
                for (int n = 0; n < 2; ++n) *(f32x4*)(of + ro + bj * 128 + n * 4) = r[bj][n] + acc[ai][bj][m][n];
        }
}

DI void epi_resid_norm(f32x4 (&acc)[2][2][4][2], const float* __restrict__ resid, float* __restrict__ of, bf16_t* __restrict__ hn, const float* __restrict__ gn,
                       float* ssqp, unsigned* cnt, int brow, int bcol, int wr, int wc, int fr, int fq) {
    const int pn = bcol >> 8;
#pragma unroll
    for (int ai = 0; ai < 2; ++ai)
#pragma unroll
        for (int m = 0; m < 4; ++m) {
            const int row = brow + ai * 128 + wr * 64 + m * 16 + fr;
            const unsigned ro = (unsigned)(row * D_ + bcol + wc * 32 + 8 * fq);
            f32x4 r[2][2];
#pragma unroll
            for (int bj = 0; bj < 2; ++bj)
#pragma unroll
                for (int n = 0; n < 2; ++n) r[bj][n] = *(const f32x4*)(resid + ro + bj * 128 + n * 4);
            float ss = 0.f;
#pragma unroll
            for (int bj = 0; bj < 2; ++bj)
#pragma unroll
                for (int n = 0; n < 2; ++n) {
                    const f32x4 v = r[bj][n] + acc[ai][bj][m][n];
                    *(f32x4*)(of + ro + bj * 128 + n * 4) = v;
                    acc[ai][bj][m][n] = v;
                    ss += (v.x * v.x + v.y * v.y) + (v.z * v.z + v.w * v.w);
                }
            ss += shx(ss, 16); ss += shx(ss, 32);
            if (fq == 0) __hip_atomic_store(ssqp + (unsigned)(row * 16 + pn * 4 + wc), ss, __ATOMIC_RELAXED, __HIP_MEMORY_SCOPE_AGENT);
            if (m & 1) __builtin_amdgcn_sched_barrier(0);
        }
    asm volatile("s_waitcnt vmcnt(0)" ::: "memory");
    __builtin_amdgcn_s_barrier();
    if (threadIdx.x == 0) {
        unsigned* c = cnt + (brow >> 8);
        (void)__hip_atomic_fetch_add(c, 1u, __ATOMIC_RELAXED, __HIP_MEMORY_SCOPE_AGENT);
        unsigned sp = 0;
        while (__hip_atomic_load(c, __ATOMIC_RELAXED, __HIP_MEMORY_SCOPE_AGENT) < 4u) { __builtin_amdgcn_s_sleep(1); if (++sp > (1u << 24)) break; }
    }
    __builtin_amdgcn_s_barrier();
    asm volatile("" ::: "memory");
#pragma unroll
    for (int ai = 0; ai < 2; ++ai)
#pragma unroll
        for (int m = 0; m < 4; ++m) {
            const int row = brow + ai * 128 + wr * 64 + m * 16 + fr;
            const float* sp4 = ssqp + (unsigned)(row * 16 + 4 * fq);
            const float sa = __hip_atomic_load(sp4, __ATOMIC_RELAXED, __HIP_MEMORY_SCOPE_AGENT), sb = __hip_atomic_load(sp4 + 1, __ATOMIC_RELAXED, __HIP_MEMORY_SCOPE_AGENT);
            const float sc = __hip_atomic_load(sp4 + 2, __ATOMIC_RELAXED, __HIP_MEMORY_SCOPE_AGENT), sd = __hip_atomic_load(sp4 + 3, __ATOMIC_RELAXED, __HIP_MEMORY_SCOPE_AGENT);
            float st = (sa + sb) + (sc + sd);
            st += shx(st, 16); st += shx(st, 32);
            const float rs = 1.0f / sqrtf(st * (1.f / D_) + EPS);
#pragma unroll
            for (int bj = 0; bj < 2; ++bj) {
                const int col = bcol + bj * 128 + wc * 32 + 8 * fq;
                const f32x4 g0 = *(const f32x4*)(gn + col), g1 = *(const f32x4*)(gn + col + 4);
                const f32x4 v0 = acc[ai][bj][m][0] * rs * g0, v1 = acc[ai][bj][m][1] * rs * g1;
                u32x4 w; w.x = pk2(v0.x, v0.y); w.y = pk2(v0.z, v0.w); w.z = pk2(v1.x, v1.y); w.w = pk2(v1.z, v1.w);
                *(u32x4*)(hn + (unsigned)(row * D_ + col)) = w;
            }
        }
}

DI void epi_store_bf16(const f32x4 (&acc)[2][2][4][2], bf16_t* __restrict__ ob, int ldo, int brow, int bcol, int wr, int wc, int fr, int fq) {
#pragma unroll
    for (int ai = 0; ai < 2; ++ai)
#pragma unroll
        for (int m = 0; m < 4; ++m) {
            bf16_t* rp = ob + (size_t)(brow + ai * 128 + wr * 64 + m * 16 + fr) * ldo + bcol + wc * 32 + 8 * fq;
#pragma unroll
            for (int bj = 0; bj < 2; ++bj)
#pragma unroll
                for (int n = 0; n < 2; ++n) { const f32x4 v = acc[ai][bj][m][n]; u32x2 w; w.x = pk2(v.x, v.y); w.y = pk2(v.z, v.w); *(u32x2*)(rp + bj * 128 + n * 4) = w; }
        }
}
DI float dpp_quad_bcast(float x, int k) {
    const int xi = __builtin_bit_cast(int, x);
    int r;
    if (k == 0) r = __builtin_amdgcn_update_dpp(xi, xi, 0x00, 0xf, 0xf, true);
    else if (k == 1) r = __builtin_amdgcn_update_dpp(xi, xi, 0x55, 0xf, 0xf, true);
    else if (k == 2) r = __builtin_amdgcn_update_dpp(xi, xi, 0xAA, 0xf, 0xf, true);
    else r = __builtin_amdgcn_update_dpp(xi, xi, 0xFF, 0xf, 0xf, true);
    return __builtin_bit_cast(float, r);
}
DI void epi_store_vt(const f32x4 (&acc)[2][2][4][2], bf16_t* __restrict__ vt, int brow, int bcol, int wr, int wc, int fr, int fq) {
    const int qi = fr & 3, qa = fr >> 2;
#pragma unroll
    for (int ai = 0; ai < 2; ++ai)
#pragma unroll
        for (int m = 0; m < 4; ++m) {
            const int row = brow + ai * 128 + wr * 64 + m * 16 + 4 * qa, b = row >> 13, s = row & 8191;
#pragma unroll
            for (int bj = 0; bj < 2; ++bj)
#pragma unroll
                for (int n = 0; n < 2; ++n) {
                    const f32x4 v = acc[ai][bj][m][n];
                    float o[4];
#pragma unroll
                    for (int k = 0; k < 4; ++k) {
                        const float t0 = dpp_quad_bcast(v.x, k), t1 = dpp_quad_bcast(v.y, k), t2 = dpp_quad_bcast(v.z, k), t3 = dpp_quad_bcast(v.w, k);
                        o[k] = qi == 0 ? t0 : (qi == 1 ? t1 : (qi == 2 ? t2 : t3));
                    }
                    const int vc = bcol - 1024 + bj * 128 + wc * 32 + 8 * fq + 4 * n + qi, hh = vc >> 7, vd = vc & 127;
                    u32x2 w; w.x = pk2(o[0], o[1]); w.y = pk2(o[2], o[3]);
                    *(u32x2*)(vt + (unsigned)(((b * 4 + hh) * 128 + vd) * S_ + s)) = w;
                }
        }
}
DI void epi_store_plane(const f32x4 (&acc)[2][2][4][2], bf16_t* __restrict__ plane, int wr, int wc, int fr, int fq) {
#pragma unroll
    for (int ai = 0; ai < 2; ++ai)
#pragma unroll
        for (int m = 0; m < 4; ++m) {
            bf16_t* rp = plane + (size_t)(ai * 128 + wr * 64 + m * 16 + fr) * 128 + wc * 32 + 8 * fq;
#pragma unroll
            for (int bj = 0; bj < 2; ++bj) { const f32x4 v0 = acc[ai][bj][m][0], v1 = acc[ai][bj][m][1];
                u32x4 w; w.x = pk2(v0.x, v0.y); w.y = pk2(v0.z, v0.w); w.z = pk2(v1.x, v1.y); w.w = pk2(v1.z, v1.w); *(u32x4*)(rp + (size_t)bj * S_ * 128) = w; }
        }
}
DI void epi_store_gate(const f32x4 (&acc)[2][2][4][2], bf16_t* __restrict__ plane, const float* __restrict__ lbt, int wr, int wc, int fr, int fq) {
#pragma unroll
    for (int bj = 0; bj < 2; ++bj)
#pragma unroll
        for (int n = 0; n < 2; ++n) {
            const int cl = bj * 128 + wc * 32 + 8 * fq + 4 * n;
            const f32x4 lb4 = *(const f32x4*)(lbt + cl);
            const float ll[4] = {lb4.x, lb4.y, lb4.z, lb4.w};
#pragma unroll
            for (int ai = 0; ai < 2; ++ai)
#pragma unroll
                for (int m = 0; m < 4; ++m) {
                    const f32x4 v = acc[ai][bj][m][n];
                    const float zz[4] = {v.x, v.y, v.z, v.w};
                    float lf[4];
#pragma unroll
                    for (int e = 0; e < 4; ++e) {
                        const float z = fminf(zz[e], 80.f);
                        const float ez = __builtin_amdgcn_exp2f(z * LOG2E);
                        const float ls = z - LN2 * __builtin_amdgcn_logf(1.f + ez);
                        const float ep = fminf(__builtin_amdgcn_rcpf(ez), 1.0686475e13f);
                        lf[e] = fminf(ls + LN2 * __builtin_amdgcn_logf(1.f + ll[e] * ep), 0.f);
                    }
                    u32x2 w; w.x = pk2(lf[0], lf[1]); w.y = pk2(lf[2], lf[3]);
                    *(u32x2*)(plane + (size_t)bj * S_ * 128 + (size_t)(ai * 128 + wr * 64 + m * 16 + fr) * 128 + wc * 32 + 8 * fq + 4 * n) = w;
                }
        }
}

template <int N> DI float dpp_ror(float x) { return __builtin_bit_cast(float, __builtin_amdgcn_update_dpp(__builtin_bit_cast(int, x), __builtin_bit_cast(int, x), 0x120 + N, 0xf, 0xf, true)); }
DI float dpp_from_prev(float x) { return __builtin_bit_cast(float, __builtin_amdgcn_update_dpp(__builtin_bit_cast(int, x), __builtin_bit_cast(int, x), 0x121, 0xf, 0xf, true)); }
DI float dpp_from_next(float x) { return __builtin_bit_cast(float, __builtin_amdgcn_update_dpp(__builtin_bit_cast(int, x), __builtin_bit_cast(int, x), 0x12f, 0xf, 0xf, true)); }
DI void epi_glu(const f32x4 (&acc)[2][2][4][2], bf16_t* __restrict__ act, bf16_t* __restrict__ halo, const float* __restrict__ cw, const float* __restrict__ cb,
                int brow, int bcol, int wr, int wc, int fr, int fq) {
    const int jt = (bcol >> 8) * 128;
#pragma unroll
    for (int n = 0; n < 2; ++n) {
        const int cl = wc * 32 + 8 * fq + 4 * n;
        f32x4 w[2][3], bb[2];
#pragma unroll
        for (int hf = 0; hf < 2; ++hf) {
#pragma unroll
            for (int k = 0; k < 3; ++k) w[hf][k] = *(const f32x4*)(cw + (size_t)k * DUP + hf * DFF + jt + cl);
            bb[hf] = *(const f32x4*)(cb + hf * DFF + jt + cl);
        }
#pragma unroll
        for (int ai = 0; ai < 2; ++ai) {
            const int row0 = brow + ai * 128 + wr * 64;
#pragma unroll
            for (int m = 0; m < 4; ++m) {
                const int rl = 4 * fr + m;
                f32x4 cv[2];
#pragma unroll
                for (int hf = 0; hf < 2; ++hf) {
                    f32x4 p, q;
#pragma unroll
                    for (int e = 0; e < 4; ++e) {
                        p[e] = m > 0 ? acc[ai][hf][m > 0 ? m - 1 : 0][n][e] : dpp_from_prev(acc[ai][hf][3][n][e]);
                        q[e] = m < 3 ? acc[ai][hf][m < 3 ? m + 1 : 3][n][e] : dpp_from_next(acc[ai][hf][0][n][e]);
                    }
                    cv[hf] = w[hf][0] * p + w[hf][1] * acc[ai][hf][m][n] + w[hf][2] * q + bb[hf];
                }
                if (rl != 0 && rl != 63) {
                    float o[4];
#pragma unroll
                    for (int e = 0; e < 4; ++e) { const float a = cv[0][e]; o[e] = a * __builtin_amdgcn_rcpf(1.f + fexp(-a)) * cv[1][e]; }
                    u32x2 ww; ww.x = pk2(o[0], o[1]); ww.y = pk2(o[2], o[3]);
                    *(u32x2*)(act + (size_t)(row0 + rl) * DFF + jt + cl) = ww;
                }
                if (rl < 2 || rl > 61) {
                    const int hr = rl < 2 ? rl : rl - 60;
                    bf16_t* hp = halo + ((size_t)(row0 >> 6) * 4 + hr) * DUP + jt + cl;
#pragma unroll
                    for (int hf = 0; hf < 2; ++hf) { const f32x4 v = acc[ai][hf][m][n]; u32x2 ww; ww.x = pk2(v.x, v.y); ww.y = pk2(v.z, v.w); *(u32x2*)(hp + hf * DFF) = ww; }
                }
                __builtin_amdgcn_sched_barrier(0);
            }
        }
    }
}

DI void phase_glu_fixup(const bf16_t* __restrict__ halo, bf16_t* __restrict__ act, const float* __restrict__ cw, const float* __restrict__ cb) {
    const int gt = obid() * NTHREADS + otid();
    constexpr int NCG = DFF / 8;
    for (int unit = gt; unit < 512 * 2 * NCG; unit += ogdim() * NTHREADS) {
        const int cgp = unit % NCG, rs = unit / NCG, strip = rs >> 1, last = rs & 1, j0 = cgp * 8;
        const int t = strip * 64 + (last ? 63 : 0);
        const bool edge = last ? ((t & 8191) == 8191) : ((t & 8191) == 0);
        const bf16_t* hp = last ? halo + ((size_t)strip * 4 + 2) * DUP : (edge ? halo : halo + ((size_t)(strip - 1) * 4 + 3) * DUP);
        const bf16_t* hc = halo + ((size_t)strip * 4 + (last ? 3 : 0)) * DUP;
        const bf16_t* hn = last ? (edge ? halo : halo + ((size_t)(strip + 1) * 4 + 0) * DUP) : halo + ((size_t)strip * 4 + 1) * DUP;
        const bool zp = !last && edge, zn = last && edge;
        float res[8];
#pragma unroll
        for (int half = 0; half < 2; ++half) { (void)half; }
        u32x4 P[2], C[2], N[2];
#pragma unroll
        for (int hf = 0; hf < 2; ++hf) { P[hf] = *(const u32x4*)(hp + hf * DFF + j0); C[hf] = *(const u32x4*)(hc + hf * DFF + j0); N[hf] = *(const u32x4*)(hn + hf * DFF + j0); }
        float cvv[2][8];
#pragma unroll
        for (int hf = 0; hf < 2; ++hf) {
            const unsigned pw[4] = {P[hf].x, P[hf].y, P[hf].z, P[hf].w}, cwd[4] = {C[hf].x, C[hf].y, C[hf].z, C[hf].w}, nw[4] = {N[hf].x, N[hf].y, N[hf].z, N[hf].w};
#pragma unroll
            for (int e = 0; e < 8; ++e) {
                const float pv = zp ? 0.f : ((e & 1) ? bfhi(pw[e >> 1]) : bflo(pw[e >> 1]));
                const float cc = (e & 1) ? bfhi(cwd[e >> 1]) : bflo(cwd[e >> 1]);
                const float nv = zn ? 0.f : ((e & 1) ? bfhi(nw[e >> 1]) : bflo(nw[e >> 1]));
                const int col = hf * DFF + j0 + e;
                cvv[hf][e] = cw[col] * pv + cw[DUP + col] * cc + cw[2 * DUP + col] * nv + cb[col];
            }
        }
#pragma unroll
        for (int e = 0; e < 8; ++e) { const float a = cvv[0][e]; res[e] = a * __builtin_amdgcn_rcpf(1.f + fexp(-a)) * cvv[1][e]; }
        u32x4 o; o.x = pk2(res[0], res[1]); o.y = pk2(res[2], res[3]); o.z = pk2(res[4], res[5]); o.w = pk2(res[6], res[7]);
        *(u32x4*)(act + (size_t)t * DFF + j0) = o;
    }
}

template <int EPI>
DI void gemm_epilogue(f32x4 (&acc)[2][2][4][2], const EpiArgs& ea, int brow, int bcol, int wr, int wc, int fr_, int fq_) {
    int fr = fr_, fq = fq_;
    asm volatile("" : "+v"(fr), "+v"(fq));
    if (EPI == EPI_RESIDN) { epi_resid_norm(acc, ea.resid, ea.of, ea.hn, ea.gn, ea.ssqp, ea.cnt, brow, bcol, wr, wc, fr, fq); return; }
    if (EPI == EPI_RESID) { epi_resid(acc, ea.resid, ea.of, brow, bcol, wr, wc, fr, fq); return; }
    if (EPI == EPI_BF16) { epi_store_bf16(acc, ea.ob, ea.ldo, brow, bcol, wr, wc, fr, fq); return; }
    if (EPI == EPI_GLU) { epi_glu(acc, ea.ob, ea.halo, ea.cw, ea.cb, brow, bcol, wr, wc, fr, fq); return; }
    if (bcol >= 1024 && bcol < 1536) epi_store_vt(acc, ea.vt, brow, bcol, wr, wc, fr, fq);
    else {
        const int g = bcol >> 9, hb = (bcol >> 7) & 3, b = brow >> 13, s0 = brow & 8191;
        bf16_t* plane = ea.ob + pidx(g, b, hb, s0);
        if (bcol >= 2048 && bcol < 3072) epi_store_gate(acc, plane, ea.lb + (bcol - 2048), wr, wc, fr, fq);
        else epi_store_plane(acc, plane, wr, wc, fr, fq);
    }
}

template <int EPI>
DI void gemm_phase(const bf16_t* __restrict__ A, const bf16_t* __restrict__ Bt, int M, int N, int K, const EpiArgs& ea) {
    extern __shared__ __attribute__((aligned(16))) char shm[];
#define SA(b, h) (shm + ((b) * 2 + (h)) * 16384)
#define SB(b, h) (shm + (4 + (b) * 2 + (h)) * 16384)
#define STAGE(P, BASE, br, kt) do { const unsigned _g = (unsigned)(br) * (unsigned)K + (unsigned)(kt) * 64u; \
    __builtin_amdgcn_global_load_lds((const unsigned*)((BASE) + (_g + toff0)), (unsigned*)((P) + tid16), 16, 0, 0); \
    __builtin_amdgcn_global_load_lds((const unsigned*)((BASE) + (_g + toff1)), (unsigned*)((P) + tid16 + 8192), 16, 0, 0); } while (0)
#define STAGEB(P, BASE, br, kt) do { const unsigned _g = (unsigned)(br) * (unsigned)K + (unsigned)(kt) * 64u; \
    __builtin_amdgcn_global_load_lds((const unsigned*)((BASE) + (_g + toffb0)), (unsigned*)((P) + tid16), 16, 0, 0); \
    __builtin_amdgcn_global_load_lds((const unsigned*)((BASE) + (_g + toffb1)), (unsigned*)((P) + tid16 + 8192), 16, 0, 0); } while (0)
#define LDA(dst, b, h) _Pragma("unroll") for (int m = 0; m < 4; ++m) _Pragma("unroll") for (int k = 0; k < 2; ++k) \
    dst[m][k] = *reinterpret_cast<const bf16x8*>(SA(b, h) + lds_byte(wr * 64 + m * 16 + fr, k * 32 + fq * 8))
#define LDB(dst, b, h) _Pragma("unroll") for (int n = 0; n < 2; ++n) _Pragma("unroll") for (int k = 0; k < 2; ++k) \
    dst[n][k] = *reinterpret_cast<const bf16x8*>(SB(b, h) + lds_byte(wc * 32 + n * 16 + fr, k * 32 + fq * 8))
#define MMA(ai, bj, At, Bt_) do { __builtin_amdgcn_s_setprio(1); \
    _Pragma("unroll") for (int m = 0; m < 4; ++m) _Pragma("unroll") for (int n = 0; n < 2; ++n) _Pragma("unroll") for (int k = 0; k < 2; ++k) \
      acc[ai][bj][m][n] = __builtin_amdgcn_mfma_f32_16x16x32_bf16(Bt_[n][k], At[m][k], acc[ai][bj][m][n], 0, 0, 0); \
    __builtin_amdgcn_s_setprio(0); } while (0)
#define WAIT_V(n) asm volatile("s_waitcnt vmcnt(" #n ")" ::: "memory")
#define WAIT_L(n) asm volatile("s_waitcnt lgkmcnt(" #n ")" ::: "memory")
#define BAR __builtin_amdgcn_s_barrier()
#define SCHED __builtin_amdgcn_sched_barrier(0)
    const int nM = M / 256, nN = N / 256;
    const int nt = K / 64;
    int pm, pn;
    if (!tile_order(0, ogdim(), obid(), nM, nN, pm, pn)) return;
    int brow = pm * 256, bcol = pn * 256, nbrow = brow, nbcol = bcol;
    bool hn = tile_order(1, ogdim(), obid(), nM, nN, pm, pn);
    if (hn) { nbrow = pm * 256; nbcol = pn * 256; }
    const int tidx = otid();
    const int wid = __builtin_amdgcn_readfirstlane(tidx >> 6), lane = tidx & 63, wr = wid >> 2, wc = wid & 3, fr = lane & 15, fq = lane >> 4;
    const int tid16 = tidx * 16;
    unsigned toff0, toff1;
    unsigned toffb0, toffb1;
    { int r_, c_; stage_rc(tid16, r_, c_); const int ra0 = EPI == EPI_GLU ? (r_ & ~63) + 4 * (r_ & 15) + ((r_ >> 4) & 3) : r_;
      toff0 = (unsigned)(ra0 * K + c_); toffb0 = (unsigned)(((r_ & ~31) + perm32(r_ & 31)) * K + c_);
      stage_rc(tid16 + 8192, r_, c_); const int ra1 = EPI == EPI_GLU ? (r_ & ~63) + 4 * (r_ & 15) + ((r_ >> 4) & 3) : r_;
      toff1 = (unsigned)(ra1 * K + c_); toffb1 = (unsigned)(((r_ & ~31) + perm32(r_ & 31)) * K + c_); }
    f32x4 acc[2][2][4][2];
#pragma unroll
    for (int a = 0; a < 2; ++a)
#pragma unroll
        for (int b = 0; b < 2; ++b)
#pragma unroll
            for (int c = 0; c < 4; ++c)
#pragma unroll
                for (int d = 0; d < 2; ++d) acc[a][b][c][d] = (f32x4){0.f, 0.f, 0.f, 0.f};
    bf16x8 At[4][2], B0[2][2], B1[2][2];
    STAGEB(SB(0, 0), Bt, bcol, 0); STAGEB(SB(0, 1), Bt, bcol + 128, 0); STAGE(SA(0, 0), A, brow, 0); STAGE(SA(0, 1), A, brow + 128, 0);
    if (wr == 1) BAR;
    WAIT_V(2); BAR;
    STAGEB(SB(1, 0), Bt, bcol, 1); STAGE(SA(1, 0), A, brow, 1); STAGEB(SB(1, 1), Bt, bcol + 128, 1);
    WAIT_V(6); BAR;
#pragma unroll 1
    for (int it = 0;; ++it) {
#pragma unroll 1
        for (int t = 0; t < nt; t += 2) {
            const bool wrap = (t + 2 >= nt);
            const int r2 = wrap ? nbrow : brow, c2 = wrap ? nbcol : bcol, k2 = wrap ? 0 : t + 2, k3 = k2 + 1;
            LDB(B0, 0, 0); LDB(B1, 0, 1); SCHED; LDA(At, 0, 0); STAGE(SA(1, 1), A, brow + 128, t + 1);
            WAIT_V(8); WAIT_L(0); BAR; MMA(0, 0, At, B0); MMA(0, 1, At, B1); BAR; SCHED;
            LDA(At, 0, 1); STAGEB(SB(0, 0), Bt, c2, k2); STAGEB(SB(0, 1), Bt, c2 + 128, k2); STAGE(SA(0, 0), A, r2, k2);
            WAIT_V(8); WAIT_L(0); BAR; MMA(1, 0, At, B0); MMA(1, 1, At, B1); BAR; SCHED;
            LDB(B0, 1, 0); LDB(B1, 1, 1); SCHED; LDA(At, 1, 0); STAGE(SA(0, 1), A, r2 + 128, k2);
            WAIT_V(8); WAIT_L(0); BAR; MMA(0, 0, At, B0); MMA(0, 1, At, B1); BAR; SCHED;
            LDA(At, 1, 1); STAGEB(SB(1, 0), Bt, c2, k3); STAGEB(SB(1, 1), Bt, c2 + 128, k3); STAGE(SA(1, 0), A, r2, k3);
            WAIT_V(8); WAIT_L(0); BAR; MMA(1, 0, At, B0); MMA(1, 1, At, B1); BAR; SCHED;
        }
        if (wr == 0) BAR;
        gemm_epilogue<EPI>(acc, ea, brow, bcol, wr, wc, fr, fq);
        if (!hn) break;
#pragma unroll
        for (int a = 0; a < 2; ++a)
#pragma unroll
            for (int b = 0; b < 2; ++b)
#pragma unroll
                for (int c = 0; c < 4; ++c)
#pragma unroll
                    for (int d = 0; d < 2; ++d) acc[a][b][c][d] = (f32x4){0.f, 0.f, 0.f, 0.f};
        brow = nbrow; bcol = nbcol;
        hn = tile_order(it + 2, ogdim(), obid(), nM, nN, pm, pn);
        if (hn) { nbrow = pm * 256; nbcol = pn * 256; }
        if (wr == 1) BAR;
    }
    WAIT_V(0);
    __syncthreads();
#undef SA
#undef SB
#undef STAGE
#undef STAGEB
#undef LDA
#undef LDB
#undef MMA
}

DI void phase_qkprep(bf16_t* proj, const float* __restrict__ rope, const float* __restrict__ kg) {
    const int tid = otid(), wave = tid >> 6, lane = tid & 63;
    const int grp = lane >> 2, tsel = grp >> 3, hc = grp & 7, qq = lane & 3;
    float g1[8], g2[8];
#pragma unroll
    for (int e = 0; e < 8; ++e) { g1[e] = kg[qq * 8 + e]; g2[e] = kg[32 + qq * 8 + e]; }
    for (int t0 = (obid() * NWAVES + wave) * 8; t0 < T_; t0 += ogdim() * NWAVES * 8) {
        u32x4 r1[4], r2[4]; f32x4 c0[4], c1[4], s0[4], s1[4];
#pragma unroll
        for (int u = 0; u < 4; ++u) {
            const int t = t0 + 2 * u + tsel;
            const bf16_t* pp = proj + pidx(1, t >> 13, hc >> 1, t & 8191) + (hc & 1) * 64 + qq * 8;
            r1[u] = *(const u32x4*)pp; r2[u] = *(const u32x4*)(pp + 32);
            const float* rp = rope + (size_t)t * 64 + qq * 8;
            c0[u] = *(const f32x4*)rp; c1[u] = *(const f32x4*)(rp + 4); s0[u] = *(const f32x4*)(rp + 32); s1[u] = *(const f32x4*)(rp + 36);
        }
#pragma unroll
        for (int u = 0; u < 4; ++u) {
            const int t = t0 + 2 * u + tsel;
            bf16_t* pp = proj + pidx(1, t >> 13, hc >> 1, t & 8191) + (hc & 1) * 64 + qq * 8;
            float x1[8], x2[8];
            x1[0] = bflo(r1[u].x); x1[1] = bfhi(r1[u].x); x1[2] = bflo(r1[u].y); x1[3] = bfhi(r1[u].y); x1[4] = bflo(r1[u].z); x1[5] = bfhi(r1[u].z); x1[6] = bflo(r1[u].w); x1[7] = bfhi(r1[u].w);
            x2[0] = bflo(r2[u].x); x2[1] = bfhi(r2[u].x); x2[2] = bflo(r2[u].y); x2[3] = bfhi(r2[u].y); x2[4] = bflo(r2[u].z); x2[5] = bfhi(r2[u].z); x2[6] = bflo(r2[u].w); x2[7] = bfhi(r2[u].w);
            float ss = 0.f;
#pragma unroll
            for (int e = 0; e < 8; ++e) ss += x1[e] * x1[e] + x2[e] * x2[e];
            ss += shx(ss, 1); ss += shx(ss, 2);
            const float rstd = 1.0f / sqrtf(ss * (1.f / 64.f) + EPS);
            const float cs[8] = {c0[u].x, c0[u].y, c0[u].z, c0[u].w, c1[u].x, c1[u].y, c1[u].z, c1[u].w}, sn[8] = {s0[u].x, s0[u].y, s0[u].z, s0[u].w, s1[u].x, s1[u].y, s1[u].z, s1[u].w};
            float y1[8], y2[8];
#pragma unroll
            for (int e = 0; e < 8; ++e) {
                const float a = x1[e] * rstd * g1[e], bq = x2[e] * rstd * g2[e];
                y1[e] = a * cs[e] - bq * sn[e]; y2[e] = bq * cs[e] + a * sn[e];
            }
            u32x4 o1, o2;
            o1.x = pk2(y1[0], y1[1]); o1.y = pk2(y1[2], y1[3]); o1.z = pk2(y1[4], y1[5]); o1.w = pk2(y1[6], y1[7]);
            o2.x = pk2(y2[0], y2[1]); o2.y = pk2(y2[2], y2[3]); o2.z = pk2(y2[4], y2[5]); o2.w = pk2(y2[6], y2[7]);
            *(u32x4*)pp = o1; *(u32x4*)(pp + 32) = o2;
        }
    }
}

constexpr int KS_BYTES = 64 * 256, VS_BYTES = 128 * 128, KV_BYTES = KS_BYTES + VS_BYTES;

template <bool SHIFT>
DI void phase_attention(const bf16_t* proj, const bf16_t* vt, bf16_t* y, const float* dog, float lam, float oscale, float mb, const float* __restrict__ rope, const float* __restrict__ qgn) {
    extern __shared__ __attribute__((aligned(16))) char shm[];
#pragma unroll 1
    for (int item = obid(); item < NB * 4 * 32; item += ogdim()) {
        const int tid = otid();
        const int wave = __builtin_amdgcn_readfirstlane(tid >> 6), lane = tid & 63, r = lane & 31, hh = lane >> 5;
        const int c = wave & 1, qg = wave >> 1;
        const int pair = ((item >> 8) << 3) | (item & 7), qb = (item >> 3) & 31, b = pair >> 2, h = pair & 3;
        const int q0 = qb * 256 + qg * 64;
        bf16x8 qf[2][4];
#pragma unroll
        for (int blk = 0; blk < 2; ++blk)
#pragma unroll
            for (int ks = 0; ks < 4; ++ks) qf[blk][ks] = *(const bf16x8*)(proj + (unsigned)(pidx(0, b, h, q0 + blk * 32 + r) + c * 64 + ks * 16 + hh * 8));
#pragma unroll
        for (int blk = 0; blk < 2; ++blk) {
            float x[4][8]; float ss = 0.f;
#pragma unroll
            for (int ks = 0; ks < 4; ++ks) {
                const u32x4 w = __builtin_bit_cast(u32x4, qf[blk][ks]);
                x[ks][0] = bflo(w.x); x[ks][1] = bfhi(w.x); x[ks][2] = bflo(w.y); x[ks][3] = bfhi(w.y); x[ks][4] = bflo(w.z); x[ks][5] = bfhi(w.z); x[ks][6] = bflo(w.w); x[ks][7] = bfhi(w.w);
#pragma unroll
                for (int e = 0; e < 8; ++e) ss += x[ks][e] * x[ks][e];
            }
            ss += shx(ss, 32);
            const float rstd = 1.0f / sqrtf(ss * (1.f / 64.f) + EPS);
            const float* rp = rope + (size_t)(b * S_ + q0 + blk * 32 + r) * 64 + hh * 8;
#pragma unroll
            for (int ks = 0; ks < 2; ++ks) {
                const f32x4 ca = *(const f32x4*)(rp + ks * 16), cb2 = *(const f32x4*)(rp + ks * 16 + 4), sa = *(const f32x4*)(rp + 32 + ks * 16), sb2 = *(const f32x4*)(rp + 32 + ks * 16 + 4);
                const f32x4 ga = *(const f32x4*)(qgn + ks * 16 + hh * 8), gb = *(const f32x4*)(qgn + ks * 16 + hh * 8 + 4), gc = *(const f32x4*)(qgn + 32 + ks * 16 + hh * 8), gd = *(const f32x4*)(qgn + 32 + ks * 16 + hh * 8 + 4);
                const float cs[8] = {ca.x, ca.y, ca.z, ca.w, cb2.x, cb2.y, cb2.z, cb2.w}, sn[8] = {sa.x, sa.y, sa.z, sa.w, sb2.x, sb2.y, sb2.z, sb2.w};
                const float g1[8] = {ga.x, ga.y, ga.z, ga.w, gb.x, gb.y, gb.z, gb.w}, g2[8] = {gc.x, gc.y, gc.z, gc.w, gd.x, gd.y, gd.z, gd.w};
                float y1[8], y2[8];
#pragma unroll
                for (int e = 0; e < 8; ++e) {
                    const float a = x[ks][e] * rstd * g1[e], bq = x[ks + 2][e] * rstd * g2[e];
                    y1[e] = (a * cs[e] - bq * sn[e]) * (0.125f * LOG2E); y2[e] = (bq * cs[e] + a * sn[e]) * (0.125f * LOG2E);
                }
                qf[blk][ks] = pack8(y1[0], y1[1], y1[2], y1[3], y1[4], y1[5], y1[6], y1[7]);
                qf[blk][ks + 2] = pack8(y2[0], y2[1], y2[2], y2[3], y2[4], y2[5], y2[6], y2[7]);
            }
        }
        f32x16 O[2][4];
#pragma unroll
        for (int blk = 0; blk < 2; ++blk)
#pragma unroll
            for (int vb = 0; vb < 4; ++vb)
#pragma unroll
                for (int i = 0; i < 16; ++i) O[blk][vb][i] = 0.f;
        float lsum[2] = {0.f, 0.f};
        unsigned ko0, ko1, vo0, vo1;
        {
            const int L0 = (2 * wave) * 64 + lane, L1 = L0 + 64;
            const int r0 = L0 >> 4, c0 = (L0 & 15) ^ (r0 & 15), r1 = L1 >> 4, c1 = (L1 & 15) ^ (r1 & 15);
            const int s0 = (r0 & ~12) | ((r0 & 4) << 1) | ((r0 & 8) >> 1), s1 = (r1 & ~12) | ((r1 & 4) << 1) | ((r1 & 8) >> 1);
            ko0 = (unsigned)(pidx(1, b, h, s0) + c0 * 8);
            ko1 = (unsigned)(pidx(1, b, h, s1) + c1 * 8);
            const int v0 = L0 >> 3, d0 = (L0 & 7) ^ ((v0 >> 1) & 7), v1 = L1 >> 3, d1 = (L1 & 7) ^ ((v1 >> 1) & 7);
            vo0 = (unsigned)(((b * 4 + h) * 128 + v0) * S_ + d0 * 8);
            vo1 = (unsigned)(((b * 4 + h) * 128 + v1) * S_ + d1 * 8);
        }
#define LOADKV(kt, buf) do { char* kb_ = shm + (buf) * KV_BYTES + (2 * wave) * 1024; char* vb_ = shm + (buf) * KV_BYTES + KS_BYTES + (2 * wave) * 1024; \
            __builtin_amdgcn_global_load_lds((const unsigned*)(proj + (ko0 + (unsigned)(kt) * (64u * 128u))), (unsigned*)(kb_), 16, 0, 0); \
            __builtin_amdgcn_global_load_lds((const unsigned*)(proj + (ko1 + (unsigned)(kt) * (64u * 128u))), (unsigned*)(kb_ + 1024), 16, 0, 0); \
            __builtin_amdgcn_global_load_lds((const unsigned*)(vt + (vo0 + (unsigned)(kt) * 64u)), (unsigned*)(vb_), 16, 0, 0); \
            __builtin_amdgcn_global_load_lds((const unsigned*)(vt + (vo1 + (unsigned)(kt) * 64u)), (unsigned*)(vb_ + 1024), 16, 0, 0); } while (0)
        __syncthreads();
        LOADKV(0, 0);
        asm volatile("s_waitcnt vmcnt(0)" ::: "memory");
        __syncthreads();
        constexpr int NT = S_ / 64;
#pragma unroll 1
        for (int kt = 0; kt < NT; ++kt) {
            if (kt + 1 < NT) LOADKV(kt + 1, (kt + 1) & 1);
            const char* ksb = shm + (kt & 1) * KV_BYTES; const char* vsb = ksb + KS_BYTES;
#pragma unroll 1
            for (int kb = 0; kb < 2; ++kb) {
                bf16x8 P[2][2];
                const int rho = kb * 32 + r;
                const char* krow_p = ksb + rho * 256 + c * 128;
                int ksw = r & 15, vsw = (r >> 1) & 7;
                asm volatile("" : "+v"(ksw), "+v"(vsw));
                bf16x8 kf[4];
#pragma unroll
                for (int ks = 0; ks < 4; ++ks) kf[ks] = *(const bf16x8*)(ksb + rho * 256 + (((c * 8 + ks * 2 + hh) ^ ksw) * 16));
                (void)krow_p;
                f32x16 X0, X1;
#pragma unroll
                for (int i = 0; i < 16; ++i) { X0[i] = 0.f; X1[i] = 0.f; }
#pragma unroll
                for (int ks = 0; ks < 4; ++ks) { X0 = MFMA32(kf[ks], qf[0][ks], X0); X1 = MFMA32(kf[ks], qf[1][ks], X1); }
                __builtin_amdgcn_sched_barrier(0);
                bf16x8 va[2][2];
                { const char* vrow_p = vsb + r * 128;
                  va[0][0] = *(const bf16x8*)(vrow_p + (((kb * 4 + hh) ^ vsw) * 16));
                  va[0][1] = *(const bf16x8*)(vrow_p + (((kb * 4 + 2 + hh) ^ vsw) * 16)); }
                {
                    float ps = 0.f;
#pragma unroll
                    for (int i = 0; i < 16; ++i) { X0[i] = __builtin_amdgcn_exp2f(SHIFT ? X0[i] - mb : X0[i]); ps += X0[i]; }
                    lsum[0] += ps;
                    { const char* vrow_p = vsb + (32 + r) * 128;
                      va[1][0] = *(const bf16x8*)(vrow_p + (((kb * 4 + hh) ^ vsw) * 16));
                      va[1][1] = *(const bf16x8*)(vrow_p + (((kb * 4 + 2 + hh) ^ vsw) * 16)); }
                    P[0][0] = pack8(X0[0], X0[1], X0[2], X0[3], X0[4], X0[5], X0[6], X0[7]);
                    P[0][1] = pack8(X0[8], X0[9], X0[10], X0[11], X0[12], X0[13], X0[14], X0[15]);
                }
                __builtin_amdgcn_sched_barrier(0);
#pragma unroll
                for (int vb = 0; vb < 2; ++vb) { O[0][vb] = MFMA32(P[0][0], va[vb][0], O[0][vb]); O[0][vb] = MFMA32(P[0][1], va[vb][1], O[0][vb]); }
                {
                    float ps = 0.f;
#pragma unroll
                    for (int i = 0; i < 16; ++i) { X1[i] = __builtin_amdgcn_exp2f(SHIFT ? X1[i] - mb : X1[i]); ps += X1[i]; }
                    lsum[1] += ps;
                    P[1][0] = pack8(X1[0], X1[1], X1[2], X1[3], X1[4], X1[5], X1[6], X1[7]);
                    P[1][1] = pack8(X1[8], X1[9], X1[10], X1[11], X1[12], X1[13], X1[14], X1[15]);
                }
                __builtin_amdgcn_sched_barrier(0);
                const bf16x8 vc0 = *(const bf16x8*)(vsb + (64 + r) * 128 + (((kb * 4 + hh) ^ vsw) * 16));
                const bf16x8 vc1 = *(const bf16x8*)(vsb + (64 + r) * 128 + (((kb * 4 + 2 + hh) ^ vsw) * 16));
#pragma unroll
                for (int vb = 0; vb < 2; ++vb) { O[1][vb] = MFMA32(P[1][0], va[vb][0], O[1][vb]); O[1][vb] = MFMA32(P[1][1], va[vb][1], O[1][vb]); }
                __builtin_amdgcn_sched_barrier(0);
                const bf16x8 vd0 = *(const bf16x8*)(vsb + (96 + r) * 128 + (((kb * 4 + hh) ^ vsw) * 16));
                const bf16x8 vd1 = *(const bf16x8*)(vsb + (96 + r) * 128 + (((kb * 4 + 2 + hh) ^ vsw) * 16));
                O[0][2] = MFMA32(P[0][0], vc0, O[0][2]); O[1][2] = MFMA32(P[1][0], vc0, O[1][2]);
                O[0][2] = MFMA32(P[0][1], vc1, O[0][2]); O[1][2] = MFMA32(P[1][1], vc1, O[1][2]);
                __builtin_amdgcn_sched_barrier(0);
                O[0][3] = MFMA32(P[0][0], vd0, O[0][3]); O[1][3] = MFMA32(P[1][0], vd0, O[1][3]);
                O[0][3] = MFMA32(P[0][1], vd1, O[0][3]); O[1][3] = MFMA32(P[1][1], vd1, O[1][3]);
                __builtin_amdgcn_sched_barrier(0);
            }
            asm volatile("s_waitcnt vmcnt(0) lgkmcnt(0)" ::: "memory");
            __builtin_amdgcn_s_barrier();
            asm volatile("" ::: "memory");
        }
#undef LOADKV
        float linv[2];
#pragma unroll
        for (int blk = 0; blk < 2; ++blk) { const float l = lsum[blk] + shx(lsum[blk], 32); linv[blk] = 1.0f / l; }
        float* xch = (float*)shm + qg * (2 * 4 * 16 * 64) + lane;
#pragma unroll
        for (int blk = 0; blk < 2; ++blk)
#pragma unroll
            for (int i = 0; i < 16; ++i) {
                const float li = shl_(linv[blk], crow(i, hh));
#pragma unroll
                for (int vb = 0; vb < 4; ++vb) O[blk][vb][i] *= li;
            }
        if (c == 1) {
#pragma unroll
            for (int blk = 0; blk < 2; ++blk)
#pragma unroll
                for (int vb = 0; vb < 4; ++vb)
#pragma unroll
                    for (int i = 0; i < 16; ++i) xch[((blk * 4 + vb) * 16 + i) * 64] = O[blk][vb][i];
        }
        __syncthreads();
        if (c == 0) {
            float gv4[4];
#pragma unroll
            for (int vb = 0; vb < 4; ++vb) gv4[vb] = dog[vb * 32 + r] * oscale;
#pragma unroll
            for (int blk = 0; blk < 2; ++blk)
#pragma unroll
                for (int i = 0; i < 16; ++i) {
                    const int qrow = crow(i, hh);
                    float o[4], ss = 0.f;
#pragma unroll
                    for (int vb = 0; vb < 4; ++vb) { o[vb] = O[blk][vb][i] - lam * xch[((blk * 4 + vb) * 16 + i) * 64]; ss += o[vb] * o[vb]; }
                    ss += shx(ss, 1); ss += shx(ss, 2); ss += shx(ss, 4); ss += shx(ss, 8); ss += shx(ss, 16);
                    const float rstd = 1.0f / sqrtf(ss * (1.f / 128.f) + EPS);
                    const unsigned yo = (unsigned)((b * S_ + q0 + blk * 32 + qrow) * D_ + h * 128 + r);
#pragma unroll
                    for (int vb = 0; vb < 4; ++vb) y[yo + vb * 32] = f2bf(o[vb] * rstd * gv4[vb]);
                }
        }
    }
}

constexpr int REL_STRIDE = 132;
constexpr int HL_REL = 0;
constexpr int HL_K = 67584;
constexpr int HL_VT = HL_K + 34816;
constexpr int HL_SEG = HL_VT + 34816;
constexpr int HL_SSQ = HL_SEG + 2048;
constexpr int HROW = 272;

template <int MODE>
DI void hgrn_cumsum(const bf16_t* proj, const float* lb, int dir, int b, int h, int m, char* shm, float* dec_out) {
    const int tid = otid(), d = tid & 127, seg = tid >> 7;
    const bf16_t* zp = proj + pidx(4 + dir, b, h, m * 128 + seg * 32) + d;
    float c[32], kv[32];
#pragma unroll
    for (int i = 0; i < 32; ++i) {
        const float lf = bf2f(zp[i * 128]);
        c[i] = lf; kv[i] = 1.f - fexp(lf);
    }
    if (dir == 0) {
#pragma unroll
        for (int i = 1; i < 32; ++i) c[i] += c[i - 1];
    } else {
#pragma unroll
        for (int i = 30; i >= 0; --i) c[i] += c[i + 1];
    }
    float* segtot = (float*)(shm + HL_SEG);
    segtot[seg * 128 + d] = (dir == 0) ? c[31] : c[0];
    __syncthreads();
    const float t0 = segtot[d], t1 = segtot[128 + d], t2 = segtot[256 + d], t3 = segtot[384 + d];
    float off;
    if (dir == 0) off = (seg > 0 ? t0 : 0.f) + (seg > 1 ? t1 : 0.f) + (seg > 2 ? t2 : 0.f);
    else off = (seg < 3 ? t3 : 0.f) + (seg < 2 ? t2 : 0.f) + (seg < 1 ? t1 : 0.f);
    if (MODE == 0) {
        const float total = (t0 + t1) + (t2 + t3);
        if (seg == 0) dec_out[d] = expf(total);
        char* kt = shm + HL_K + d * HROW + seg * 64;
#pragma unroll
        for (int i = 0; i < 32; i += 8) {
            float e[8];
#pragma unroll
            for (int j = 0; j < 8; ++j) e[j] = kv[i + j] * fexp(total - (c[i + j] + off));
            *(bf16x8*)(kt + i * 2) = pack8(e[0], e[1], e[2], e[3], e[4], e[5], e[6], e[7]);
        }
    } else {
        float* rel = (float*)(shm + HL_REL);
        bf16_t* kl = (bf16_t*)(shm + HL_K);
#pragma unroll
        for (int i = 0; i < 32; ++i) {
            const int t = seg * 32 + i;
            rel[t * REL_STRIDE + d] = c[i] + off;
            kl[t * (HROW / 2) + d] = f2bf(kv[i]);
        }
    }
}

DI void hgrn_load_vt(const bf16_t* proj, int b, int h, int m, char* shm) {
    const int tid = otid(), s = tid & 127, vg = tid >> 7;
    const bf16_t* ip = proj + pidx(6, b, h, m * 128 + s) + vg * 32;
    bf16_t* vtl = (bf16_t*)(shm + HL_VT);
#pragma unroll
    for (int j = 0; j < 4; ++j) {
        const u32x4 w = *(const u32x4*)(ip + j * 8);
        const unsigned ww[4] = {w.x, w.y, w.z, w.w};
#pragma unroll
        for (int e = 0; e < 4; ++e) {
            const int v = vg * 32 + j * 8 + e * 2;
            vtl[v * (HROW / 2) + s] = (bf16_t)(ww[e] & 0xffffu);
            vtl[(v + 1) * (HROW / 2) + s] = (bf16_t)(ww[e] >> 16);
        }
    }
}

DI void phase_hgrn_pass1(const bf16_t* __restrict__ proj, const float* __restrict__ lb, bf16_t* __restrict__ states, float* __restrict__ dec) {
    extern __shared__ __attribute__((aligned(16))) char shm[];
    constexpr int P1_K1 = HL_REL, P1_SEG = HL_REL + 40960;
#pragma unroll 1
    for (int item = obid(); item < NB * 4 * 64; item += ogdim()) {
        const int tid = otid(), wave = __builtin_amdgcn_readfirstlane(tid >> 6), lane = tid & 63, r = lane & 31, hh = lane >> 5;
        const int b = item >> 8, h = (item >> 6) & 3, m = item & 63;
        const int d = tid & 127, seg = tid >> 7;
        __syncthreads();
        hgrn_load_vt(proj, b, h, m, shm);
        float c0[32], c1[32];
        {
            const bf16_t* z0 = proj + pidx(4, b, h, m * 128 + seg * 32) + d;
            const bf16_t* z1 = proj + pidx(5, b, h, m * 128 + seg * 32) + d;
#pragma unroll
            for (int i = 0; i < 32; ++i) { c0[i] = bf2f(z0[i * 128]); c1[i] = bf2f(z1[i * 128]); }
        }
        float* segtot = (float*)(shm + P1_SEG);
        {
            float s0 = 0.f, s1 = 0.f;
#pragma unroll
            for (int i = 0; i < 32; ++i) { s0 += c0[i]; s1 += c1[i]; }
            segtot[seg * 128 + d] = s0; segtot[512 + seg * 128 + d] = s1;
        }
        __syncthreads();
        {
            const float a0 = segtot[d], a1 = segtot[128 + d], a2 = segtot[256 + d], a3 = segtot[384 + d];
            const float e0 = segtot[512 + d], e1 = segtot[640 + d], e2 = segtot[768 + d], e3 = segtot[896 + d];
            float run0 = (seg < 3 ? a3 : 0.f) + (seg < 2 ? a2 : 0.f) + (seg < 1 ? a1 : 0.f);
            float run1 = (seg > 0 ? e0 : 0.f) + (seg > 1 ? e1 : 0.f) + (seg > 2 ? e2 : 0.f);
            if (seg == 0) {
                const int s0i = ((0 * 4 + b) * 4 + h) * 64 + m, s1i = ((1 * 4 + b) * 4 + h) * 64 + m;
                dec[(size_t)s0i * 128 + d] = expf((a0 + a1) + (a2 + a3));
                dec[(size_t)s1i * 128 + d] = expf((e0 + e1) + (e2 + e3));
            }
            float k0[32], k1[32];
            float p0 = fexp(run0), p1 = fexp(run1);
#pragma unroll
            for (int i = 31; i >= 0; --i) { const float fi = fexp(c0[i]); k0[i] = (1.f - fi) * p0; p0 *= fi; }
#pragma unroll
            for (int i = 0; i < 32; ++i) { const float fi = fexp(c1[i]); k1[i] = (1.f - fi) * p1; p1 *= fi; }
            char* kt0 = shm + HL_K + d * HROW + seg * 64;
            char* kt1 = shm + P1_K1 + d * HROW + seg * 64;
#pragma unroll
            for (int i = 0; i < 32; i += 8) {
                *(bf16x8*)(kt0 + i * 2) = pack8(k0[i], k0[i + 1], k0[i + 2], k0[i + 3], k0[i + 4], k0[i + 5], k0[i + 6], k0[i + 7]);
                *(bf16x8*)(kt1 + i * 2) = pack8(k1[i], k1[i + 1], k1[i + 2], k1[i + 3], k1[i + 4], k1[i + 5], k1[i + 6], k1[i + 7]);
            }
        }
        __syncthreads();
        {
            const int dir = wave >> 2, vblk = wave & 3;
            const char* kbase = shm + (dir ? P1_K1 : HL_K);
            f32x16 L[4];
#pragma unroll
            for (int j = 0; j < 4; ++j)
#pragma unroll
                for (int i = 0; i < 16; ++i) L[j][i] = 0.f;
#pragma unroll
            for (int ks = 0; ks < 8; ++ks) {
                const bf16x8 af = *(const bf16x8*)(shm + HL_VT + (vblk * 32 + r) * HROW + (ks * 16 + hh * 8) * 2);
#pragma unroll
                for (int j = 0; j < 4; ++j) {
                    const bf16x8 bf = *(const bf16x8*)(kbase + (j * 32 + r) * HROW + (ks * 16 + hh * 8) * 2);
                    L[j] = MFMA32(af, bf, L[j]);
                }
            }
            const int sidx = ((dir * 4 + b) * 4 + h) * 64 + m;
            bf16_t* sp = states + (size_t)sidx * 16384;
#pragma unroll
            for (int j = 0; j < 4; ++j)
#pragma unroll
                for (int i = 0; i < 16; ++i) sp[(vblk * 32 + crow(i, hh)) * 128 + j * 32 + r] = f2bf(L[j][i]);
        }
    }
}

DI void phase_hgrn_scan(bf16_t* states, const float* __restrict__ dec) {
    const int gt = obid() * NTHREADS + otid();
    for (int u = gt; u < 32 * 4096; u += ogdim() * NTHREADS) {
        const int chain = u >> 12, e4 = u & 4095, dir = chain >> 4;
        const int d0 = (e4 * 4) & 127;
        bf16_t* sp = states + (size_t)chain * 64 * 16384 + e4 * 4;
        const float* dp = dec + (size_t)chain * 64 * 128 + d0;
        float c0 = 0.f, c1 = 0.f, c2 = 0.f, c3 = 0.f;
#pragma unroll 1
        for (int mb = 0; mb < 64; mb += 16) {
            u32x2 w[16]; f32x4 dv[16];
#pragma unroll
            for (int k = 0; k < 16; ++k) { const int m = dir ? 63 - (mb + k) : mb + k; w[k] = *(const u32x2*)(sp + (size_t)m * 16384); dv[k] = *(const f32x4*)(dp + m * 128); }
#pragma unroll
            for (int k = 0; k < 16; ++k) {
                const int m = dir ? 63 - (mb + k) : mb + k;
                u32x2 o; o.x = pk2(c0, c1); o.y = pk2(c2, c3);
                *(u32x2*)(sp + (size_t)m * 16384) = o;
                c0 = dv[k].x * c0 + bflo(w[k].x); c1 = dv[k].y * c1 + bfhi(w[k].x); c2 = dv[k].z * c2 + bflo(w[k].y); c3 = dv[k].w * c3 + bfhi(w[k].y);
            }
        }
    }
}

constexpr int H3_QH = 0, H3_KC = 34816, H3_KHT = 69632, H3_VT = 104448, H3_GDEC = 139264, H3_SSQ = 141312;
#define MFMA16(a, b, c) __builtin_amdgcn_mfma_f32_16x16x32_bf16((a), (b), (c), 0, 0, 0)
DI bf16x8 ld2x8(const char* p, int second_off) { const u32x2 lo = *(const u32x2*)p, hi = *(const u32x2*)(p + second_off); u32x4 w; w.x = lo.x; w.y = lo.y; w.z = hi.x; w.w = hi.y; return __builtin_bit_cast(bf16x8, w); }

DI void hgrn3_stage(const bf16_t* proj, const float* lb, int dir, int b, int h, int m, char* shm, const float (&qv)[32]) {
    const int tid = otid(), d = tid & 127, seg = tid >> 7;
    const bf16_t* zp = proj + pidx(4 + dir, b, h, m * 128 + seg * 32) + d;
    float f[32], ec[32];
#pragma unroll
    for (int i = 0; i < 32; ++i) f[i] = fexp(bf2f(zp[i * 128]));
    if (dir == 0) {
        ec[0] = f[0];
#pragma unroll
        for (int i = 1; i < 32; ++i) ec[i] = ec[i - 1] * f[i];
    } else {
        ec[31] = f[31];
#pragma unroll
        for (int i = 30; i >= 0; --i) ec[i] = ec[i + 1] * f[i];
    }
    ((float*)(shm + H3_GDEC))[seg * 128 + d] = dir == 0 ? ec[31] : ec[0];
    bf16_t* qh = (bf16_t*)(shm + H3_QH); bf16_t* kc = (bf16_t*)(shm + H3_KC);
#pragma unroll
    for (int i = 0; i < 32; ++i) {
        const int t = seg * 32 + i;
        qh[t * 136 + d] = f2bf(qv[i] * ec[i]);
        kc[t * 136 + d] = f2bf((1.f - f[i]) * fminf(__builtin_amdgcn_rcpf(ec[i]), 1e30f));
    }
    float rem = 1.f;
    if (dir == 0) {
#pragma unroll
        for (int i = 31; i >= 0; --i) { const float fi = f[i]; ec[i] = (1.f - fi) * rem; rem *= fi; }
    } else {
#pragma unroll
        for (int i = 0; i < 32; ++i) { const float fi = f[i]; ec[i] = (1.f - fi) * rem; rem *= fi; }
    }
    char* kt = shm + H3_KHT + d * HROW + seg * 64;
#pragma unroll
    for (int i = 0; i < 32; i += 8)
        *(bf16x8*)(kt + i * 2) = pack8(ec[i], ec[i + 1], ec[i + 2], ec[i + 3], ec[i + 4], ec[i + 5], ec[i + 6], ec[i + 7]);
}

template <int DIR>
DI void hgrn3_mma(const char* shm, f32x4 (&S)[8], f32x4 (&O)[4][2], int v0, int j, int q4) {
#pragma unroll
    for (int step = 0; step < 4; ++step) {
        const int I = DIR == 0 ? step : 3 - step;
        {
            bf16x8 sb[4];
#pragma unroll
            for (int a = 0; a < 4; ++a) sb[a] = pack8(S[2 * a][0], S[2 * a][1], S[2 * a][2], S[2 * a][3], S[2 * a + 1][0], S[2 * a + 1][1], S[2 * a + 1][2], S[2 * a + 1][3]);
#pragma unroll
            for (int tt = 0; tt < 2; ++tt)
#pragma unroll
                for (int a = 0; a < 4; ++a) {
                    const bf16x8 af = ld2x8(shm + H3_QH + (32 * I + 16 * tt + j) * HROW + (32 * a + 4 * q4) * 2, 32);
                    O[I][tt] = MFMA16(af, sb[a], O[I][tt]);
                }
        }
        {
            f32x4 XT[2][2];
#pragma unroll
            for (int st = 0; st < 2; ++st)
#pragma unroll
                for (int tt = 0; tt < 2; ++tt) XT[st][tt] = (f32x4){0.f, 0.f, 0.f, 0.f};
#pragma unroll
            for (int ks = 0; ks < 4; ++ks) {
                bf16x8 kf[2], qf[2];
#pragma unroll
                for (int st = 0; st < 2; ++st) kf[st] = *(const bf16x8*)(shm + H3_KC + (32 * I + 16 * st + j) * HROW + (32 * ks + 8 * q4) * 2);
#pragma unroll
                for (int tt = 0; tt < 2; ++tt) qf[tt] = *(const bf16x8*)(shm + H3_QH + (32 * I + 16 * tt + j) * HROW + (32 * ks + 8 * q4) * 2);
#pragma unroll
                for (int st = 0; st < 2; ++st)
#pragma unroll
                    for (int tt = 0; tt < 2; ++tt) XT[st][tt] = MFMA16(kf[st], qf[tt], XT[st][tt]);
            }
#pragma unroll
            for (int st = 0; st < 2; ++st)
#pragma unroll
                for (int tt = 0; tt < 2; ++tt)
#pragma unroll
                    for (int rg = 0; rg < 4; ++rg) {
                        const int s = 16 * st + 4 * q4 + rg, t = 16 * tt + j;
                        const bool keep = DIR == 0 ? (s <= t) : (s >= t);
                        XT[st][tt][rg] = keep ? XT[st][tt][rg] : 0.f;
                    }
            const bf16x8 vf = ld2x8(shm + H3_VT + (v0 + j) * HROW + (32 * I + 4 * q4) * 2, 32);
#pragma unroll
            for (int tt = 0; tt < 2; ++tt) {
                const bf16x8 pa = pack8(XT[0][tt][0], XT[0][tt][1], XT[0][tt][2], XT[0][tt][3], XT[1][tt][0], XT[1][tt][1], XT[1][tt][2], XT[1][tt][3]);
                O[I][tt] = MFMA16(pa, vf, O[I][tt]);
            }
        }
        {
            const float* gd = (const float*)(shm + H3_GDEC) + I * 128 + 4 * q4;
            const bf16x8 vb = *(const bf16x8*)(shm + H3_VT + (v0 + j) * HROW + (32 * I + 8 * q4) * 2);
#pragma unroll
            for (int dt = 0; dt < 8; ++dt) {
                const f32x4 g4 = *(const f32x4*)(gd + 16 * dt);
                S[dt] = S[dt] * g4;
                const bf16x8 ka = *(const bf16x8*)(shm + H3_KHT + (16 * dt + j) * HROW + (32 * I + 8 * q4) * 2);
                S[dt] = MFMA16(ka, vb, S[dt]);
            }
        }
    }
}

DI void phase_hgrn_pass3(const bf16_t* __restrict__ proj, const float* __restrict__ lb, const bf16_t* __restrict__ states, bf16_t* __restrict__ y, const float* __restrict__ hog) {
    extern __shared__ __attribute__((aligned(16))) char shm[];
#pragma unroll 1
    for (int item = obid(); item < NB * 4 * 64; item += ogdim()) {
        const int tid = otid(), wave = __builtin_amdgcn_readfirstlane(tid >> 6), lane = tid & 63, j = lane & 15, q4 = lane >> 4;
        const int b = item >> 8, h = (item >> 6) & 3, m = item & 63;
        const size_t tok0 = (size_t)b * S_ + m * 128;
        const int v0 = wave * 16;
        __syncthreads();
        {
            const int s = tid & 127, vg = tid >> 7;
            const bf16_t* ip = proj + pidx(6, b, h, m * 128 + s) + vg * 32;
            bf16_t* vtl = (bf16_t*)(shm + H3_VT);
#pragma unroll
            for (int jj = 0; jj < 4; ++jj) {
                const u32x4 w = *(const u32x4*)(ip + jj * 8);
                const unsigned ww[4] = {w.x, w.y, w.z, w.w};
#pragma unroll
                for (int e = 0; e < 4; ++e) {
                    const int v = vg * 32 + jj * 8 + e * 2;
                    vtl[v * 136 + s] = (bf16_t)(ww[e] & 0xffffu);
                    vtl[(v + 1) * 136 + s] = (bf16_t)(ww[e] >> 16);
                }
            }
        }
        float qv[32];
        {
            const int d = tid & 127, seg = tid >> 7;
            const bf16_t* qp = proj + pidx(3, b, h, m * 128 + seg * 32) + d;
#pragma unroll
            for (int i = 0; i < 32; ++i) qv[i] = bf2f(qp[i * 128]);
        }
        f32x4 O[4][2];
#pragma unroll
        for (int I = 0; I < 4; ++I)
#pragma unroll
            for (int tt = 0; tt < 2; ++tt) O[I][tt] = (f32x4){0.f, 0.f, 0.f, 0.f};
#pragma unroll 1
        for (int dir = 0; dir < 2; ++dir) {
            hgrn3_stage(proj, lb, dir, b, h, m, shm, qv);
            const int sidx = ((dir * 4 + b) * 4 + h) * 64 + m;
            const bf16_t* sp = states + (size_t)sidx * 16384 + (v0 + j) * 128 + 4 * q4;
            f32x4 S[8];
#pragma unroll
            for (int dt = 0; dt < 8; ++dt) { const u32x2 w = *(const u32x2*)(sp + 16 * dt); S[dt] = (f32x4){bflo(w.x), bfhi(w.x), bflo(w.y), bfhi(w.y)}; }
            __syncthreads();
            if (dir == 0) hgrn3_mma<0>(shm, S, O, v0, j, q4); else hgrn3_mma<1>(shm, S, O, v0, j, q4);
            __syncthreads();
        }
        float* ssq = (float*)(shm + H3_SSQ);
#pragma unroll
        for (int I = 0; I < 4; ++I)
#pragma unroll
            for (int tt = 0; tt < 2; ++tt)
#pragma unroll
                for (int rg = 0; rg < 4; ++rg) {
                    float ss = O[I][tt][rg] * O[I][tt][rg];
                    ss += dpp_ror<8>(ss); ss += dpp_ror<4>(ss); ss += dpp_ror<2>(ss); ss += dpp_ror<1>(ss);
                    if (j == 0) ssq[wave * 128 + 32 * I + 16 * tt + 4 * q4 + rg] = ss;
                }
        __syncthreads();
        if (tid < 128) { float s = 0.f;
#pragma unroll
            for (int w = 0; w < 8; ++w) s += ssq[w * 128 + tid];
            ((float*)(shm + H3_GDEC))[tid] = 1.0f / sqrtf(s * (1.f / 128.f) + EPS); }
        __syncthreads();
        const float* rstdv = (const float*)(shm + H3_GDEC);
        const float og = hog[v0 + j];
        bf16_t gl[4][2][4];
#pragma unroll
        for (int I = 0; I < 4; ++I)
#pragma unroll
            for (int tt = 0; tt < 2; ++tt)
#pragma unroll
                for (int rg = 0; rg < 4; ++rg) gl[I][tt][rg] = proj[pidx(7, b, h, m * 128 + 32 * I + 16 * tt + 4 * q4 + rg) + v0 + j];
#pragma unroll
        for (int I = 0; I < 4; ++I)
#pragma unroll
            for (int tt = 0; tt < 2; ++tt)
#pragma unroll
                for (int rg = 0; rg < 4; ++rg) {
                    const int tl = 32 * I + 16 * tt + 4 * q4 + rg;
                    const size_t tok = tok0 + tl;
                    const float g = bf2f(gl[I][tt][rg]);
                    const float sg = g * __builtin_amdgcn_rcpf(1.f + fexp(-g));
                    y[tok * D_ + 512 + h * 128 + v0 + j] = f2bf(O[I][tt][rg] * rstdv[tl] * og * sg);
                }
    }
}

DI void phase_glu(const bf16_t* __restrict__ u, bf16_t* __restrict__ act, const float* __restrict__ cw, const float* __restrict__ cb) {
    const int gt = obid() * NTHREADS + otid();
    constexpr int NCG = DFF / 8, NSTRIP = 16384 / 32;
    for (int unit = gt; unit < NSTRIP * NCG; unit += ogdim() * NTHREADS) {
        const int strip = unit / NCG, cgp = unit % NCG, j0 = cgp * 8, r0 = strip * 32;
        float w[2][3][8], bb[2][8];
#pragma unroll
        for (int hf = 0; hf < 2; ++hf) {
#pragma unroll
            for (int k = 0; k < 3; ++k) {
                const f32x4 a = *(const f32x4*)(cw + (size_t)k * DUP + hf * DFF + j0), c = *(const f32x4*)(cw + (size_t)k * DUP + hf * DFF + j0 + 4);
                w[hf][k][0] = a.x; w[hf][k][1] = a.y; w[hf][k][2] = a.z; w[hf][k][3] = a.w; w[hf][k][4] = c.x; w[hf][k][5] = c.y; w[hf][k][6] = c.z; w[hf][k][7] = c.w;
            }
            const f32x4 a = *(const f32x4*)(cb + hf * DFF + j0), c = *(const f32x4*)(cb + hf * DFF + j0 + 4);
            bb[hf][0] = a.x; bb[hf][1] = a.y; bb[hf][2] = a.z; bb[hf][3] = a.w; bb[hf][4] = c.x; bb[hf][5] = c.y; bb[hf][6] = c.z; bb[hf][7] = c.w;
        }
        u32x4 pa, pv, ca, cv, na, nv;
        const u32x4 zero = {0u, 0u, 0u, 0u};
        const bool first = (r0 & 8191) == 0;
        pa = first ? zero : *(const u32x4*)(u + (size_t)(r0 - 1) * DUP + j0);
        pv = first ? zero : *(const u32x4*)(u + (size_t)(r0 - 1) * DUP + DFF + j0);
        ca = *(const u32x4*)(u + (size_t)r0 * DUP + j0);
        cv = *(const u32x4*)(u + (size_t)r0 * DUP + DFF + j0);
#pragma unroll 4
        for (int i = 0; i < 32; ++i) {
            const int rr = r0 + i;
            const bool last = (rr & 8191) == 8191;
            na = last ? zero : *(const u32x4*)(u + (size_t)(rr + 1) * DUP + j0);
            nv = last ? zero : *(const u32x4*)(u + (size_t)(rr + 1) * DUP + DFF + j0);
            const unsigned pA[4] = {pa.x, pa.y, pa.z, pa.w}, cA[4] = {ca.x, ca.y, ca.z, ca.w}, nA[4] = {na.x, na.y, na.z, na.w};
            const unsigned pV[4] = {pv.x, pv.y, pv.z, pv.w}, cV[4] = {cv.x, cv.y, cv.z, cv.w}, nV[4] = {nv.x, nv.y, nv.z, nv.w};
            float res[8];
#pragma unroll
            for (int e = 0; e < 4; ++e) {
                const float a0 = w[0][0][2 * e] * bflo(pA[e]) + w[0][1][2 * e] * bflo(cA[e]) + w[0][2][2 * e] * bflo(nA[e]) + bb[0][2 * e];
                const float a1 = w[0][0][2 * e + 1] * bfhi(pA[e]) + w[0][1][2 * e + 1] * bfhi(cA[e]) + w[0][2][2 * e + 1] * bfhi(nA[e]) + bb[0][2 * e + 1];
                const float v0 = w[1][0][2 * e] * bflo(pV[e]) + w[1][1][2 * e] * bflo(cV[e]) + w[1][2][2 * e] * bflo(nV[e]) + bb[1][2 * e];
                const float v1 = w[1][0][2 * e + 1] * bfhi(pV[e]) + w[1][1][2 * e + 1] * bfhi(cV[e]) + w[1][2][2 * e + 1] * bfhi(nV[e]) + bb[1][2 * e + 1];
                res[2 * e] = a0 / (1.f + expf(-a0)) * v0; res[2 * e + 1] = a1 / (1.f + expf(-a1)) * v1;
            }
            u32x4 o; o.x = pk2(res[0], res[1]); o.y = pk2(res[2], res[3]); o.z = pk2(res[4], res[5]); o.w = pk2(res[6], res[7]);
            *(u32x4*)(act + (size_t)rr * DFF + j0) = o;
            pa = ca; pv = cv; ca = na; cv = nv;
        }
    }
}

#define XB_TMO      128
#define XB_XCNT(j)  (256  + 64 * (j))
#define XB_XSUB(j)  (1280 + 64 * (j))
#define XB_XGEN(j)  (2304 + 64 * (j))
#define XB_TOP      3328
#define XB_TOPGEN   3392
#define XCD_BAR_WORDS 3456
#define XB_SPIN_CAP (1u << 22)
DI unsigned xb_ld(unsigned* p) { return __hip_atomic_load(p, __ATOMIC_RELAXED, __HIP_MEMORY_SCOPE_AGENT); }
DI unsigned xb_add(unsigned* p, unsigned v) { return __hip_atomic_fetch_add(p, v, __ATOMIC_RELAXED, __HIP_MEMORY_SCOPE_AGENT); }
DI unsigned xb_xcc_id() { return (unsigned)__builtin_amdgcn_s_getreg((3 << 11) | 20) & 0xFu; }
#define XB_SPIN(cond, bar) do { unsigned _sp = 0; while (cond) { __builtin_amdgcn_s_sleep(1); \
    if ((++_sp & 255u) == 0u) { if (xb_ld(&(bar)[XB_TMO])) break; if (_sp > XB_SPIN_CAP) { atomicAdd(&(bar)[XB_TMO], 1u); break; } } } } while (0)
struct XcdBarrier { unsigned* bar; unsigned x; volatile unsigned* st; };
DI XcdBarrier xcd_barrier_post(unsigned* bar, volatile unsigned* st) {
    XcdBarrier b; b.bar = bar; b.x = xb_xcc_id(); b.st = st;
    if (threadIdx.x == 0) (void)xb_add(&bar[XB_XCNT(b.x)], 1u);
    return b;
}
DI void xcd_barrier_complete(unsigned* bar, unsigned x, unsigned& nloc, unsigned& nx) {
    const unsigned G = gridDim.x;
    unsigned sum, cnt, mine, sp = 0u;
    for (;;) {
        sum = 0u; cnt = 0u; mine = 0u;
#pragma unroll 1
        for (unsigned j = 0; j < 16; ++j) { const unsigned c = xb_ld(&bar[XB_XCNT(j)]); sum += c; cnt += (c > 0u) ? 1u : 0u; mine = (j == x) ? c : mine; }
        if (sum == G) break;
        __builtin_amdgcn_s_sleep(1);
        if ((++sp & 255u) == 0u) { if (xb_ld(&bar[XB_TMO])) break; if (sp > XB_SPIN_CAP) { atomicAdd(&bar[XB_TMO], 1u); break; } }
    }
    nloc = mine > 0u ? mine : 1u; nx = cnt > 0u ? cnt : 1u;
}
DI void xcd_barrier(const XcdBarrier& b) {
    asm volatile("s_waitcnt vmcnt(0)" ::: "memory");
    __syncthreads();
    if (threadIdx.x == 0) {
        unsigned* bar = b.bar;
        __builtin_amdgcn_s_waitcnt(0);
        const unsigned nloc = b.st[0], nx = b.st[1];
        const unsigned old = xb_add(&bar[XB_XSUB(b.x)], 1u);
        const unsigned gen = old / nloc;
        if (old + 1u == (gen + 1u) * nloc) {
            __builtin_amdgcn_fence(__ATOMIC_RELEASE, "agent");
            asm volatile("s_waitcnt vmcnt(0)" ::: "memory");
            const unsigned og = xb_add(&bar[XB_TOP], 1u);
            const unsigned tg = og / nx;
            if (og + 1u == (tg + 1u) * nx) xb_add(&bar[XB_TOPGEN], 1u);
            else XB_SPIN(xb_ld(&bar[XB_TOPGEN]) == tg, bar);
            __builtin_amdgcn_fence(__ATOMIC_ACQUIRE, "agent");
            xb_add(&bar[XB_XGEN(b.x)], 1u);
            asm volatile("s_waitcnt vmcnt(0)" ::: "memory");
        } else {
            XB_SPIN(xb_ld(&bar[XB_XGEN(b.x)]) == gen, bar);
            __builtin_amdgcn_fence(__ATOMIC_ACQUIRE, "agent");
            asm volatile("s_waitcnt vmcnt(0)" ::: "memory");
        }
    }
    __syncthreads();
}

enum { PH_PROLOGUE = 0, PH_NORM1, PH_INPROJ, PH_PREP, PH_SCAN, PH_MIX, PH_OUTPROJ, PH_NORM2, PH_UP, PH_GLU, PH_DOWN };

template <int PH>
DI void run_phase(const Params& p, int l, int hf) {
    extern __shared__ __attribute__((aligned(16))) char shm[];
    unsigned char* ws = p.ws;
    bf16_t* hbuf = (bf16_t*)(ws + OFF_H);
    bf16_t* states = (bf16_t*)(ws + OFF_H);
    float* dec = (float*)(ws + OFF_DEC);
    bf16_t* vt = (bf16_t*)(ws + OFF_VT);
    bf16_t* proj = (bf16_t*)(ws + OFF_PROJ);
    bf16_t* ybuf = (bf16_t*)(ws + OFF_Y);
    bf16_t* halo = (bf16_t*)(ws + OFF_HALO);
    bf16_t* actbuf = (bf16_t*)(ws + OFF_ACT);
    const float* rope = (const float*)(ws + OFF_ROPE);
    const float* misc = (const float*)(ws + OFF_MISC);
    const float* xin = l == 0 ? p.x : p.out;
    if (PH == PH_PROLOGUE) { phase_prologue(p, shm); phase_rmsnorm(p.x, p.mix_g, hbuf); }
    if (PH == PH_NORM1) phase_rmsnorm(xin, p.mix_g + l * D_, hbuf);
    if (PH == PH_INPROJ) { EpiArgs ea; ea.ob = proj; ea.ldo = DIN; ea.vt = vt; ea.resid = nullptr; ea.of = nullptr; ea.lb = misc + l * 1024; ea.cw = nullptr; ea.cb = nullptr; ea.halo = nullptr; ea.ssqp = nullptr; ea.cnt = nullptr; ea.gn = nullptr; ea.hn = nullptr;
        gemm_phase<EPI_PROJ>(hbuf, (const bf16_t*)(ws + OFF_WIN) + (size_t)l * 4096 * 1024, T_, DIN, D_, ea); }
    if (PH == PH_PREP) { phase_qkprep(proj, rope, p.kg + l * 64); phase_hgrn_pass1(proj, misc + l * 1024, states, dec); }
    if (PH == PH_SCAN) phase_hgrn_scan(states, dec);
    if (PH == PH_MIX) {
        const float lamv = __int_as_float(__builtin_amdgcn_readfirstlane(__float_as_int(misc[2048 + l])));
        const float oscv = __int_as_float(__builtin_amdgcn_readfirstlane(__float_as_int(misc[2052 + l])));
        const float mbv = __int_as_float(__builtin_amdgcn_readfirstlane(__float_as_int(misc[2050 + l])));
        if (mbv > 60.f) phase_attention<true>(proj, vt, ybuf, p.dog + l * 128, lamv, oscv, mbv, rope, p.qg + l * 64);
        else phase_attention<false>(proj, vt, ybuf, p.dog + l * 128, lamv, oscv, 0.f, rope, p.qg + l * 64);
        phase_hgrn_pass3(proj, misc + l * 1024, states, ybuf, p.hog + l * 128);
    }
    if (PH == PH_OUTPROJ) { EpiArgs ea; ea.ob = nullptr; ea.ldo = 0; ea.vt = nullptr; ea.resid = xin; ea.of = p.out; ea.lb = nullptr; ea.cw = nullptr; ea.cb = nullptr; ea.halo = nullptr;
        ea.hn = hbuf; ea.gn = p.ffn_g + l * D_; ea.ssqp = (float*)(ws + OFF_SSQ) + (size_t)(2 * l) * T_ * 16; ea.cnt = (unsigned*)(ws + OFF_BAR) + CNT_WORD + (2 * l) * 128;
        gemm_phase<EPI_RESIDN>(ybuf, (const bf16_t*)(ws + OFF_WOUT) + (size_t)l * 1024 * 1024, T_, D_, D_, ea); }
    if (PH == PH_NORM2) phase_rmsnorm(p.out, p.ffn_g + l * D_, hbuf);
    if (PH == PH_UP) { EpiArgs ea; ea.ob = actbuf; ea.ldo = DFF; ea.vt = nullptr; ea.resid = nullptr; ea.of = nullptr; ea.lb = nullptr;
        ea.cw = p.conv_w + (size_t)l * 3 * DUP; ea.cb = p.conv_b + (size_t)l * DUP; ea.halo = halo; ea.ssqp = nullptr; ea.cnt = nullptr; ea.gn = nullptr; ea.hn = nullptr;
        gemm_phase<EPI_GLU>(hbuf, (const bf16_t*)(ws + OFF_WUP) + (size_t)l * 5632 * 1024, T_, DUP, D_, ea); }
    if (PH == PH_GLU) phase_glu_fixup(halo, actbuf, p.conv_w + (size_t)l * 3 * DUP, p.conv_b + (size_t)l * DUP);
    if (PH == PH_DOWN) { EpiArgs ea; ea.ob = nullptr; ea.ldo = 0; ea.vt = nullptr; ea.resid = p.out; ea.of = p.out; ea.lb = nullptr; ea.cw = nullptr; ea.cb = nullptr; ea.halo = nullptr;
        ea.hn = nullptr; ea.gn = nullptr; ea.ssqp = nullptr; ea.cnt = nullptr;
        if (l == 0) { ea.hn = hbuf; ea.gn = p.mix_g + D_; ea.ssqp = (float*)(ws + OFF_SSQ) + (size_t)1 * T_ * 16; ea.cnt = (unsigned*)(ws + OFF_BAR) + CNT_WORD + 128;
            gemm_phase<EPI_RESIDN>(actbuf, (const bf16_t*)(ws + OFF_WDN), T_, D_, DFF, ea); }
        else gemm_phase<EPI_RESID>(actbuf, (const bf16_t*)(ws + OFF_WDN) + (size_t)l * 1024 * 2816, T_, D_, DFF, ea); }
}

#ifndef FUSED
#define FUSED 1
#endif

#if FUSED
__global__ void __launch_bounds__(NTHREADS) fwd_megakernel(Params p) {
    extern __shared__ __attribute__((aligned(16))) char shm[];
    cg::grid_group grid = cg::this_grid();
    volatile unsigned* st = (volatile unsigned*)(shm + LDS_MAIN);
    if (threadIdx.x == 0) { st[0] = 0u; st[1] = 0u; }
    __syncthreads();
    const XcdBarrier xb = xcd_barrier_post((unsigned*)(p.ws + OFF_BAR), st);
    run_phase<PH_PROLOGUE>(p, 0, 0); grid.sync();
    if (threadIdx.x == 0) { unsigned nloc, nx; xcd_barrier_complete(xb.bar, xb.x, nloc, nx); st[0] = nloc; st[1] = nx; }
    __syncthreads();
#pragma unroll 1
    for (int l = 0; l < 2; ++l) {
        run_phase<PH_INPROJ>(p, l, 0); xcd_barrier(xb);
        run_phase<PH_PREP>(p, l, 0); xcd_barrier(xb);
        run_phase<PH_SCAN>(p, l, 0); xcd_barrier(xb);
        run_phase<PH_MIX>(p, l, 0); xcd_barrier(xb);
        run_phase<PH_OUTPROJ>(p, l, 0); xcd_barrier(xb);
        run_phase<PH_UP>(p, l, 0); xcd_barrier(xb);
        run_phase<PH_GLU>(p, l, 0); xcd_barrier(xb);
        run_phase<PH_DOWN>(p, l, 0); xcd_barrier(xb);
    }
}
#else
template <int PH>
__global__ void __launch_bounds__(NTHREADS) k_phase(Params p, int l, int hf) { run_phase<PH>(p, l, hf); }
#endif

template <int PH>
static void launch_phase(const Params& p, int l, int hf, int grid, hipStream_t stream) {
#if !FUSED
    static bool attr_set = false;
    if (!attr_set) { (void)hipFuncSetAttribute((const void*)k_phase<PH>, hipFuncAttributeMaxDynamicSharedMemorySize, LDS_BYTES); attr_set = true; }
    hipLaunchKernelGGL(k_phase<PH>, dim3(grid), dim3(NTHREADS), LDS_BYTES, stream, p, l, hf);
#endif
}

extern "C" void kernel_launch(void* const* d_in, const int* in_sizes, int n_in, void* d_out, int out_size, void* d_ws, size_t ws_size, hipStream_t stream) {
    static int grid_blocks = 0;
    if (grid_blocks == 0) {
        if (n_in != 19 || ws_size < WS_END) { fprintf(stderr, "kernel_launch: unexpected n_in %d or ws_size %zu (< %zu)\n", n_in, ws_size, (size_t)WS_END); grid_blocks = -1; return; }
        int dev = 0, cus = 0, per_cu = 1;
        (void)hipGetDevice(&dev);
        (void)hipDeviceGetAttribute(&cus, hipDeviceAttributeMultiprocessorCount, dev);
#if FUSED
        (void)hipFuncSetAttribute((const void*)fwd_megakernel, hipFuncAttributeMaxDynamicSharedMemorySize, LDS_BYTES);
        (void)hipOccupancyMaxActiveBlocksPerMultiprocessor(&per_cu, (const void*)fwd_megakernel, NTHREADS, LDS_BYTES);
        if (per_cu < 1) per_cu = 1;
#endif
        grid_blocks = cus * per_cu;
        (void)hipGetLastError();
    }
    if (grid_blocks < 0) return;
    Params p{};
    p.x = (const float*)d_in[0]; p.pos = (const int*)d_in[1]; p.mix_g = (const float*)d_in[2]; p.w_in = (const float*)d_in[3];
    p.qg = (const float*)d_in[4]; p.kg = (const float*)d_in[5]; p.lq1 = (const float*)d_in[6]; p.lk1 = (const float*)d_in[7];
    p.lq2 = (const float*)d_in[8]; p.lk2 = (const float*)d_in[9]; p.dog = (const float*)d_in[10]; p.lbl = (const float*)d_in[11];
    p.hog = (const float*)d_in[12]; p.w_out = (const float*)d_in[13]; p.ffn_g = (const float*)d_in[14]; p.w_up = (const float*)d_in[15];
    p.conv_w = (const float*)d_in[16]; p.conv_b = (const float*)d_in[17]; p.w_down = (const float*)d_in[18];
    p.out = (float*)d_out; p.ws = (unsigned char*)d_ws;
#if FUSED
    (void)hipMemsetAsync((char*)d_ws + OFF_BAR, 0, 16384, stream);
    void* args[] = {&p};
    hipError_t e = hipLaunchCooperativeKernel((const void*)fwd_megakernel, dim3(grid_blocks), dim3(NTHREADS), args, LDS_BYTES, stream);
    if (e != hipSuccess) fprintf(stderr, "cooperative launch failed: %s (grid %d)\n", hipGetErrorString(e), grid_blocks);
#else
    const int g = grid_blocks;
    launch_phase<PH_PROLOGUE>(p, 0, 0, g, stream);
    for (int l = 0; l < 2; ++l) {
        launch_phase<PH_NORM1>(p, l, 0, g, stream);
        launch_phase<PH_INPROJ>(p, l, 0, g, stream);
        launch_phase<PH_PREP>(p, l, 0, g, stream);
        launch_phase<PH_SCAN>(p, l, 0, g, stream);
        launch_phase<PH_MIX>(p, l, 0, g, stream);
        launch_phase<PH_OUTPROJ>(p, l, 0, g, stream);
        launch_phase<PH_NORM2>(p, l, 0, g, stream);
        for (int hf = 0; hf < 2; ++hf) {
            launch_phase<PH_UP>(p, l, hf, g, stream);
            launch_phase<PH_GLU>(p, l, hf, g, stream);
            launch_phase<PH_DOWN>(p, l, hf, g, stream);
        }
    }
#endif
}
```

```cpp
#include <hip/hip_runtime.h>
#include <hip/hip_cooperative_groups.h>
#include <cstdio>
#include <cstdint>
namespace cg = cooperative_groups;

typedef unsigned short bf16_t;
typedef short bf16x8 __attribute__((ext_vector_type(8)));
typedef short s16x4 __attribute__((ext_vector_type(4)));
typedef float f32x2 __attribute__((ext_vector_type(2)));
typedef float f32x4 __attribute__((ext_vector_type(4)));
typedef float f32x16 __attribute__((ext_vector_type(16)));
typedef unsigned u32x2 __attribute__((ext_vector_type(2)));
typedef unsigned u32x4 __attribute__((ext_vector_type(4)));
typedef __bf16 bfv2 __attribute__((ext_vector_type(2)));

#define DI __device__ __forceinline__

constexpr int T_ = 32768, S_ = 8192, NB = 4, D_ = 1024, DIN = 4096, DFF = 2816, DUP = 5632;
constexpr int NTHREADS = 512, NWAVES = 8;
constexpr int LDS_MAIN = 144 * 1024;
constexpr int LDS_BYTES = LDS_MAIN + 16;
constexpr float EPS = 1e-6f;
constexpr float LOG2E = 1.4426950408889634f, LN2 = 0.6931471805599453f;

constexpr size_t OFF_WIN = 0;
constexpr size_t OFF_WOUT = OFF_WIN + 2ull * 4096 * 1024 * 2;
constexpr size_t OFF_WUP = OFF_WOUT + 2ull * 1024 * 1024 * 2;
constexpr size_t OFF_WDN = OFF_WUP + 2ull * 5632 * 1024 * 2;
constexpr size_t OFF_ROPE = OFF_WDN + 2ull * 1024 * 2816 * 2;
constexpr size_t OFF_MISC = OFF_ROPE + (size_t)T_ * 64 * 4;
constexpr size_t OFF_H = OFF_MISC + 65536;
constexpr size_t OFF_DEC = OFF_H + (size_t)T_ * 1024 * 2;
constexpr size_t OFF_VT = OFF_DEC + 2048ull * 128 * 4;
constexpr size_t OFF_PROJ = OFF_VT + (size_t)T_ * 512 * 2;
constexpr size_t OFF_Y = OFF_PROJ + (size_t)T_ * 4096 * 2;
constexpr size_t OFF_BAR = OFF_Y + (size_t)T_ * 1024 * 2;
constexpr size_t OFF_SSQ = OFF_BAR + 16384;
constexpr size_t WS_END = OFF_SSQ + 3ull * T_ * 16 * 4;
constexpr int CNT_WORD = 3584;
constexpr size_t OFF_ACT = OFF_PROJ;
constexpr size_t OFF_HALO = OFF_Y;

struct Params {
    const float* x; const int* pos; const float* mix_g; const float* w_in; const float* qg; const float* kg;
    const float* lq1; const float* lk1; const float* lq2; const float* lk2; const float* dog; const float* lbl; const float* hog;
    const float* w_out; const float* ffn_g; const float* w_up; const float* conv_w; const float* conv_b; const float* w_down;
    float* out; unsigned char* ws;
};

DI unsigned pk2(float lo, float hi) { f32x2 v = {lo, hi}; bfv2 r = __builtin_convertvector(v, bfv2); return __builtin_bit_cast(unsigned, r); }
DI float bf2f(bf16_t h) { return __uint_as_float((unsigned)h << 16); }
DI float bflo(unsigned u) { return __uint_as_float(u << 16); }
DI float bfhi(unsigned u) { return __uint_as_float(u & 0xffff0000u); }
DI bf16_t f2bf(float f) { return (bf16_t)(pk2(f, 0.f) & 0xffffu); }
DI bf16x8 pack8(float a0, float a1, float a2, float a3, float a4, float a5, float a6, float a7) {
    u32x4 p; p.x = pk2(a0, a1); p.y = pk2(a2, a3); p.z = pk2(a4, a5); p.w = pk2(a6, a7); return __builtin_bit_cast(bf16x8, p);
}
DI int otid() { int t = threadIdx.x; asm volatile("" : "+v"(t)); return t; }
DI float shx(float v, int m) { const int l = otid() & 63; return __builtin_bit_cast(float, __builtin_amdgcn_ds_bpermute((l ^ m) << 2, __builtin_bit_cast(int, v))); }
DI float shl_(float v, int srclane) { return __builtin_bit_cast(float, __builtin_amdgcn_ds_bpermute(srclane << 2, __builtin_bit_cast(int, v))); }
DI float wave_sum(float v) {
#pragma unroll
    for (int o = 1; o < 64; o <<= 1) v += shx(v, o);
    return v;
}
DI float wave_max(float v) {
#pragma unroll
    for (int o = 1; o < 64; o <<= 1) v = fmaxf(v, shx(v, o));
    return v;
}
DI size_t pidx(int g, int b, int h, int s) { return ((size_t)((g * 4 + b) * 4 + h) * S_ + s) * 128; }
DI int obid() { int b = blockIdx.x; asm volatile("" : "+s"(b)); return b; }
DI int ogdim() { int g = gridDim.x; asm volatile("" : "+s"(g)); return g; }
DI float fexp(float x) { return __builtin_amdgcn_exp2f(x * LOG2E); }
DI int crow(int reg, int h) { return (reg & 3) + 8 * (reg >> 2) + 4 * h; }
#define MFMA32(a, b, c) __builtin_amdgcn_mfma_f32_32x32x16_bf16((a), (b), (c), 0, 0, 0)

DI void transpose_load(const float* W, int N, int nblk, int item, float* scr, int lane) {
    const int kb = item / nblk, nb = item % nblk, k0 = 64 * kb, n0 = 64 * nb;
    const int n4 = lane & 15, kq = lane >> 4;
    f32x4 v[16];
#pragma unroll
    for (int i = 0; i < 16; ++i) v[i] = *(const f32x4*)(W + (size_t)(k0 + 4 * i + kq) * N + n0 + 4 * n4);
#pragma unroll
    for (int i = 0; i < 16; ++i) { float* s = scr + (4 * i + kq) * 65 + 4 * n4; s[0] = v[i].x; s[1] = v[i].y; s[2] = v[i].z; s[3] = v[i].w; }
}
DI void transpose_store(bf16_t* WT, int K, int nblk, int item, const float* scr, int lane, bool glu_perm) {
    const int kb = item / nblk, nb = item % nblk, k0 = 64 * kb;
    int n0 = 64 * nb;
    if (glu_perm) n0 = n0 < DFF ? ((n0 >> 7) << 8) + (n0 & 127) : (((n0 - DFF) >> 7) << 8) + 128 + ((n0 - DFF) & 127);
    const int c = lane & 7;
#pragma unroll
    for (int j = 0; j < 8; ++j) {
        const int n = (lane >> 3) + 8 * j; const float* s = scr + (8 * c) * 65 + n;
        u32x4 o; o.x = pk2(s[0], s[65]); o.y = pk2(s[130], s[195]); o.z = pk2(s[260], s[325]); o.w = pk2(s[390], s[455]);
        *(u32x4*)(WT + (size_t)(n0 + n) * K + k0 + 8 * c) = o;
    }
}

DI void phase_prologue(const Params& p, char* shm) {
    const int tid = otid(), wave = tid >> 6, lane = tid & 63;
    float* scr = (float*)shm + wave * (64 * 65);
    constexpr int I_IN = 16 * 64, I_OUT = 16 * 16, I_UP = 16 * 88, I_DN = 44 * 16, I_L = I_IN + I_OUT + I_UP + I_DN, NITEMS = 2 * I_L;
    for (int base = obid() * NWAVES; base < NITEMS; base += ogdim() * NWAVES) {
        const int it = base + wave; const bool act = it < NITEMS;
        const float* W = nullptr; bf16_t* WT = nullptr; int K = 0, N = 0, r = 0;
        if (act) {
            const int l = it / I_L; r = it % I_L;
            if (r < I_IN) { W = p.w_in + (size_t)l * 1024 * 4096; WT = (bf16_t*)(p.ws + OFF_WIN) + (size_t)l * 4096 * 1024; K = 1024; N = 4096; }
            else if ((r -= I_IN) < I_OUT) { W = p.w_out + (size_t)l * 1024 * 1024; WT = (bf16_t*)(p.ws + OFF_WOUT) + (size_t)l * 1024 * 1024; K = 1024; N = 1024; }
            else if ((r -= I_OUT) < I_UP) { W = p.w_up + (size_t)l * 1024 * 5632; WT = (bf16_t*)(p.ws + OFF_WUP) + (size_t)l * 5632 * 1024; K = 1024; N = 5632; }
            else { r -= I_UP; W = p.w_down + (size_t)l * 2816 * 1024; WT = (bf16_t*)(p.ws + OFF_WDN) + (size_t)l * 1024 * 2816; K = 2816; N = 1024; }
            transpose_load(W, N, N / 64, r, scr, lane);
        }
        __syncthreads();
        if (act) transpose_store(WT, K, N / 64, r, scr, lane, N == DUP);
        __syncthreads();
    }
    float* rope = (float*)(p.ws + OFF_ROPE);
    for (int e = obid() * NTHREADS + tid; e < T_ * 32; e += ogdim() * NTHREADS) {
        const int t = e >> 5, i = e & 31;
        const float inv_freq = exp2f(-(float)i * (13.287712379549449f / 32.f));
        const float ang = (float)p.pos[t] * inv_freq;
        double rev = (double)ang * 0.15915494309189535; rev -= rint(rev);
        const float fr = (float)rev;
        rope[(size_t)t * 64 + i] = __builtin_amdgcn_cosf(fr);
        rope[(size_t)t * 64 + 32 + i] = __builtin_amdgcn_sinf(fr);
    }
    if (obid() == 0) {
        float* misc = (float*)(p.ws + OFF_MISC);
        for (int e = tid; e < 1024; e += NTHREADS) {
            const float a0 = p.lbl[e], a1 = p.lbl[1024 + e];
            const float m = fmaxf(a0, a1), e0 = expf(a0 - m), e1 = expf(a1 - m), p0 = e0 / (e0 + e1), p1 = e1 / (e0 + e1);
            const float l0 = p0 - p0, l1 = (p0 + p1) - p0;
            misc[e] = fminf(fmaxf(l0, 0.f), 1.f - 1e-4f);
            misc[1024 + e] = fminf(fmaxf(l1, 0.f), 1.f - 1e-4f);
        }
        if (wave < 2) {
            const int l = wave;
            const float s1 = wave_sum(p.lq1[l * 64 + lane] * p.lk1[l * 64 + lane]);
            const float s2 = wave_sum(p.lq2[l * 64 + lane] * p.lk2[l * 64 + lane]);
            const float mq = wave_max(fabsf(p.qg[l * 64 + lane])), mk = wave_max(fabsf(p.kg[l * 64 + lane]));
            const float lam_init = 0.8f - 0.6f * expf(-0.3f * (float)l);
            if (lane == 0) { misc[2048 + l] = expf(s1) - expf(s2) + lam_init; misc[2050 + l] = 8.f * mq * mk * LOG2E + 0.5f; misc[2052 + l] = 1.f - lam_init; }
        }
    }
}

DI void phase_rmsnorm(const float* __restrict__ x, const float* __restrict__ g, bf16_t* __restrict__ h) {
    const int tid = otid(), wave = tid >> 6, lane = tid & 63;
    f32x4 gv[4];
#pragma unroll
    for (int j = 0; j < 4; ++j) gv[j] = ((const f32x4*)g)[lane + 64 * j];
    for (int row0 = (obid() * NWAVES + wave) * 4; row0 < T_; row0 += ogdim() * NWAVES * 4) {
        f32x4 v[4][4]; float s[4];
#pragma unroll
        for (int rr = 0; rr < 4; ++rr) {
            const f32x4* xr = (const f32x4*)(x + (size_t)(row0 + rr) * D_) + lane;
            s[rr] = 0.f;
#pragma unroll
            for (int j = 0; j < 4; ++j) { v[rr][j] = xr[64 * j]; s[rr] += (v[rr][j].x * v[rr][j].x + v[rr][j].y * v[rr][j].y) + (v[rr][j].z * v[rr][j].z + v[rr][j].w * v[rr][j].w); }
        }
#pragma unroll
        for (int o = 1; o < 64; o <<= 1) {
#pragma unroll
            for (int rr = 0; rr < 4; ++rr) s[rr] += shx(s[rr], o);
        }
#pragma unroll
        for (int rr = 0; rr < 4; ++rr) {
            const float rstd = 1.0f / sqrtf(s[rr] * (1.f / D_) + EPS);
            u32x2* o = (u32x2*)(h + (size_t)(row0 + rr) * D_) + lane;
#pragma unroll
            for (int j = 0; j < 4; ++j) {
                u32x2 w; w.x = pk2(v[rr][j].x * rstd * gv[j].x, v[rr][j].y * rstd * gv[j].y); w.y = pk2(v[rr][j].z * rstd * gv[j].z, v[rr][j].w * rstd * gv[j].w);
                o[64 * j] = w;
            }
        }
    }
}

DI int lds_byte(int r, int c) { const int st = (r >> 4) * 2 + (c >> 5), rr = r & 15, cc = c & 31, ob = rr * 64 + cc * 2; return st * 1024 + (ob ^ (((ob >> 9) & 1) << 5)); }
DI int perm32(int rho) { const int n = rho >> 4, i = rho & 15; return 8 * (i >> 2) + 4 * n + (i & 3); }
DI void stage_rc(int b, int& R, int& C) { const int st = b / 1024, sb = b % 1024, swz = sb ^ (((sb >> 9) & 1) << 5); R = (st >> 1) * 16 + swz / 64; C = (st & 1) * 32 + (swz % 64) / 2; }

DI bool tile_order(int i, int G, int c, int nM, int nN, int& pm, int& pn) {
    const long L = (long)i * G + c; const int nwg = nM * nN; if (L >= nwg) return false;
    int wgid = (int)L; { const int q = nwg / 8, r = nwg % 8, xcd = wgid % 8, off = wgid / 8; wgid = (xcd < r ? xcd * (q + 1) : r * (q + 1) + (xcd - r) * q) + off; }
    const int nig = 8 * nN, gid = wgid / nig, fm = gid * 8, gsz = (nM - fm) < 8 ? (nM - fm) : 8;
    pm = fm + ((wgid % nig) % gsz); pn = (wgid % nig) / gsz; return true;
}

enum { EPI_PROJ = 0, EPI_RESID = 1, EPI_BF16 = 2, EPI_GLU = 3, EPI_RESIDN = 4 };
struct EpiArgs { bf16_t* ob; int ldo; bf16_t* vt; const float* resid; float* of; const float* lb; const float* cw; const float* cb; bf16_t* halo; float* ssqp; unsigned* cnt; const float* gn; bf16_t* hn; };

DI void epi_resid(const f32x4 (&acc)[2][2][4][2], const float* __restrict__ resid, float* __restrict__ of, int brow, int bcol, int wr, int wc, int fr, int fq) {
#pragma unroll
    for (int ai = 0; ai < 2; ++ai)
#pragma unroll
        for (int m = 0; m < 4; ++m) {
            const size_t ro = (size_t)(brow + ai * 128 + wr * 64 + m * 16 + fr) * D_ + bcol + wc * 32 + 8 * fq;
            f32x4 r[2][2];
#pragma unroll
            for (int bj = 0; bj < 2; ++bj)
#pragma unroll
                for (int n = 0; n < 2; ++n) r[bj][n] = *(const f32x4*)(resid + ro + bj * 128 + n * 4);
#pragma unroll
            for (int bj = 0; bj < 2; ++bj)
#pragma unroll
                for (int n = 0; n < 2; ++n) *(f32x4*)(of + ro + bj * 128 + n * 4) = r[bj][n] + acc[ai][bj][m][n];
        }
}

DI void epi_resid_norm(f32x4 (&acc)[2][2][4][2], const float* __restrict__ resid, float* __restrict__ of, bf16_t* __restrict__ hn, const float* __restrict__ gn,
                       float* ssqp, unsigned* cnt, int brow, int bcol, int wr, int wc, int fr, int fq) {
    const int pn = bcol >> 8;
#pragma unroll
    for (int ai = 0; ai < 2; ++ai)
#pragma unroll
        for (int m = 0; m < 4; ++m) {
            const int row = brow + ai * 128 + wr * 64 + m * 16 + fr;
            const unsigned ro = (unsigned)(row * D_ + bcol + wc * 32 + 8 * fq);
            f32x4 r[2][2];
#pragma unroll
            for (int bj = 0; bj < 2; ++bj)
#pragma unroll
                for (int n = 0; n < 2; ++n) r[bj][n] = *(const f32x4*)(resid + ro + bj * 128 + n * 4);
            float ss = 0.f;
#pragma unroll
            for (int bj = 0; bj < 2; ++bj)
#pragma unroll
                for (int n = 0; n < 2; ++n) {
                    const f32x4 v = r[bj][n] + acc[ai][bj][m][n];
                    *(f32x4*)(of + ro + bj * 128 + n * 4) = v;
                    acc[ai][bj][m][n] = v;
                    ss += (v.x * v.x + v.y * v.y) + (v.z * v.z + v.w * v.w);
                }
            ss += shx(ss, 16); ss += shx(ss, 32);
            if (fq == 0) __hip_atomic_store(ssqp + (unsigned)(row * 16 + pn * 4 + wc), ss, __ATOMIC_RELAXED, __HIP_MEMORY_SCOPE_AGENT);
            if (m & 1) __builtin_amdgcn_sched_barrier(0);
        }
    asm volatile("s_waitcnt vmcnt(0)" ::: "memory");
    __builtin_amdgcn_s_barrier();
    if (threadIdx.x == 0) {
        unsigned* c = cnt + (brow >> 8);
        (void)__hip_atomic_fetch_add(c, 1u, __ATOMIC_RELAXED, __HIP_MEMORY_SCOPE_AGENT);
        unsigned sp = 0;
        while (__hip_atomic_load(c, __ATOMIC_RELAXED, __HIP_MEMORY_SCOPE_AGENT) < 4u) { __builtin_amdgcn_s_sleep(1); if (++sp > (1u << 24)) break; }
    }
    __builtin_amdgcn_s_barrier();
    asm volatile("" ::: "memory");
#pragma unroll
    for (int ai = 0; ai < 2; ++ai)
#pragma unroll
        for (int m = 0; m < 4; ++m) {
            const int row = brow + ai * 128 + wr * 64 + m * 16 + fr;
            const float* sp4 = ssqp + (unsigned)(row * 16 + 4 * fq);
            const float sa = __hip_atomic_load(sp4, __ATOMIC_RELAXED, __HIP_MEMORY_SCOPE_AGENT), sb = __hip_atomic_load(sp4 + 1, __ATOMIC_RELAXED, __HIP_MEMORY_SCOPE_AGENT);
            const float sc = __hip_atomic_load(sp4 + 2, __ATOMIC_RELAXED, __HIP_MEMORY_SCOPE_AGENT), sd = __hip_atomic_load(sp4 + 3, __ATOMIC_RELAXED, __HIP_MEMORY_SCOPE_AGENT);
            float st = (sa + sb) + (sc + sd);
            st += shx(st, 16); st += shx(st, 32);
            const float rs = 1.0f / sqrtf(st * (1.f / D_) + EPS);
#pragma unroll
            for (int bj = 0; bj < 2; ++bj) {
                const int col = bcol + bj * 128 + wc * 32 + 8 * fq;
                const f32x4 g0 = *(const f32x4*)(gn + col), g1 = *(const f32x4*)(gn + col + 4);
                const f32x4 v0 = acc[ai][bj][m][0] * rs * g0, v1 = acc[ai][bj][m][1] * rs * g1;
                u32x4 w; w.x = pk2(v0.x, v0.y); w.y = pk2(v0.z, v0.w); w.z = pk2(v1.x, v1.y); w.w = pk2(v1.z, v1.w);
                *(u32x4*)(hn + (unsigned)(row * D_ + col)) = w;
            }
        }
}

DI void epi_store_bf16(const f32x4 (&acc)[2][2][4][2], bf16_t* __restrict__ ob, int ldo, int brow, int bcol, int wr, int wc, int fr, int fq) {
#pragma unroll
    for (int ai = 0; ai < 2; ++ai)
#pragma unroll
        for (int m = 0; m < 4; ++m) {
            bf16_t* rp = ob + (size_t)(brow + ai * 128 + wr * 64 + m * 16 + fr) * ldo + bcol + wc * 32 + 8 * fq;
#pragma unroll
            for (int bj = 0; bj < 2; ++bj)
#pragma unroll
                for (int n = 0; n < 2; ++n) { const f32x4 v = acc[ai][bj][m][n]; u32x2 w; w.x = pk2(v.x, v.y); w.y = pk2(v.z, v.w); *(u32x2*)(rp + bj * 128 + n * 4) = w; }
        }
}
DI float dpp_quad_bcast(float x, int k) {
    const int xi = __builtin_bit_cast(int, x);
    int r;
    if (k == 0) r = __builtin_amdgcn_update_dpp(xi, xi, 0x00, 0xf, 0xf, true);
    else if (k == 1) r = __builtin_amdgcn_update_dpp(xi, xi, 0x55, 0xf, 0xf, true);
    else if (k == 2) r = __builtin_amdgcn_update_dpp(xi, xi, 0xAA, 0xf, 0xf, true);
    else r = __builtin_amdgcn_update_dpp(xi, xi, 0xFF, 0xf, 0xf, true);
    return __builtin_bit_cast(float, r);
}
DI void epi_store_vt(const f32x4 (&acc)[2][2][4][2], bf16_t* __restrict__ vt, int brow, int bcol, int wr, int wc, int fr, int fq) {
    const int qi = fr & 3, qa = fr >> 2;
#pragma unroll
    for (int ai = 0; ai < 2; ++ai)
#pragma unroll
        for (int m = 0; m < 4; ++m) {
            const int row = brow + ai * 128 + wr * 64 + m * 16 + 4 * qa, b = row >> 13, s = row & 8191;
#pragma unroll
            for (int bj = 0; bj < 2; ++bj)
#pragma unroll
                for (int n = 0; n < 2; ++n) {
                    const f32x4 v = acc[ai][bj][m][n];
                    float o[4];
#pragma unroll
                    for (int k = 0; k < 4; ++k) {
                        const float t0 = dpp_quad_bcast(v.x, k), t1 = dpp_quad_bcast(v.y, k), t2 = dpp_quad_bcast(v.z, k), t3 = dpp_quad_bcast(v.w, k);
                        o[k] = qi == 0 ? t0 : (qi == 1 ? t1 : (qi == 2 ? t2 : t3));
                    }
                    const int vc = bcol - 1024 + bj * 128 + wc * 32 + 8 * fq + 4 * n + qi, hh = vc >> 7, vd = vc & 127;
                    u32x2 w; w.x = pk2(o[0], o[1]); w.y = pk2(o[2], o[3]);
                    *(u32x2*)(vt + (unsigned)(((b * 4 + hh) * 128 + vd) * S_ + s)) = w;
                }
        }
}
DI void epi_store_plane(const f32x4 (&acc)[2][2][4][2], bf16_t* __restrict__ plane, int wr, int wc, int fr, int fq) {
#pragma unroll
    for (int ai = 0; ai < 2; ++ai)
#pragma unroll
        for (int m = 0; m < 4; ++m) {
            bf16_t* rp = plane + (size_t)(ai * 128 + wr * 64 + m * 16 + fr) * 128 + wc * 32 + 8 * fq;
#pragma unroll
            for (int bj = 0; bj < 2; ++bj) { const f32x4 v0 = acc[ai][bj][m][0], v1 = acc[ai][bj][m][1];
                u32x4 w; w.x = pk2(v0.x, v0.y); w.y = pk2(v0.z, v0.w); w.z = pk2(v1.x, v1.y); w.w = pk2(v1.z, v1.w); *(u32x4*)(rp + (size_t)bj * S_ * 128) = w; }
        }
}
DI void epi_store_gate(const f32x4 (&acc)[2][2][4][2], bf16_t* __restrict__ plane, const float* __restrict__ lbt, int wr, int wc, int fr, int fq) {
#pragma unroll
    for (int bj = 0; bj < 2; ++bj)
#pragma unroll
        for (int n = 0; n < 2; ++n) {
            const int cl = bj * 128 + wc * 32 + 8 * fq + 4 * n;
            const f32x4 lb4 = *(const f32x4*)(lbt + cl);
            const float ll[4] = {lb4.x, lb4.y, lb4.z, lb4.w};
#pragma unroll
            for (int ai = 0; ai < 2; ++ai)
#pragma unroll
                for (int m = 0; m < 4; ++m) {
                    const f32x4 v = acc[ai][bj][m][n];
                    const float zz[4] = {v.x, v.y, v.z, v.w};
                    float lf[4];
#pragma unroll
                    for (int e = 0; e < 4; ++e) {
                        const float z = fminf(zz[e], 80.f);
                        const float ez = __builtin_amdgcn_exp2f(z * LOG2E);
                        const float ls = z - LN2 * __builtin_amdgcn_logf(1.f + ez);
                        const float ep = fminf(__builtin_amdgcn_rcpf(ez), 1.0686475e13f);
                        lf[e] = fminf(ls + LN2 * __builtin_amdgcn_logf(1.f + ll[e] * ep), 0.f);
                    }
                    u32x2 w; w.x = pk2(lf[0], lf[1]); w.y = pk2(lf[2], lf[3]);
                    *(u32x2*)(plane + (size_t)bj * S_ * 128 + (size_t)(ai * 128 + wr * 64 + m * 16 + fr) * 128 + wc * 32 + 8 * fq + 4 * n) = w;
                }
        }
}

template <int N> DI float dpp_ror(float x) { return __builtin_bit_cast(float, __builtin_amdgcn_update_dpp(__builtin_bit_cast(int, x), __builtin_bit_cast(int, x), 0x120 + N, 0xf, 0xf, true)); }
DI float dpp_from_prev(float x) { return __builtin_bit_cast(float, __builtin_amdgcn_update_dpp(__builtin_bit_cast(int, x), __builtin_bit_cast(int, x), 0x121, 0xf, 0xf, true)); }
DI float dpp_from_next(float x) { return __builtin_bit_cast(float, __builtin_amdgcn_update_dpp(__builtin_bit_cast(int, x), __builtin_bit_cast(int, x), 0x12f, 0xf, 0xf, true)); }
DI void epi_glu(const f32x4 (&acc)[2][2][4][2], bf16_t* __restrict__ act, bf16_t* __restrict__ halo, const float* __restrict__ cw, const float* __restrict__ cb,
                int brow, int bcol, int wr, int wc, int fr, int fq) {
    const int jt = (bcol >> 8) * 128;
#pragma unroll
    for (int n = 0; n < 2; ++n) {
        const int cl = wc * 32 + 8 * fq + 4 * n;
        f32x4 w[2][3], bb[2];
#pragma unroll
        for (int hf = 0; hf < 2; ++hf) {
#pragma unroll
            for (int k = 0; k < 3; ++k) w[hf][k] = *(const f32x4*)(cw + (size_t)k * DUP + hf * DFF + jt + cl);
            bb[hf] = *(const f32x4*)(cb + hf * DFF + jt + cl);
        }
#pragma unroll
        for (int ai = 0; ai < 2; ++ai) {
            const int row0 = brow + ai * 128 + wr * 64;
#pragma unroll
            for (int m = 0; m < 4; ++m) {
                const int rl = 4 * fr + m;
                f32x4 cv[2];
#pragma unroll
                for (int hf = 0; hf < 2; ++hf) {
                    f32x4 p, q;
#pragma unroll
                    for (int e = 0; e < 4; ++e) {
                        p[e] = m > 0 ? acc[ai][hf][m > 0 ? m - 1 : 0][n][e] : dpp_from_prev(acc[ai][hf][3][n][e]);
                        q[e] = m < 3 ? acc[ai][hf][m < 3 ? m + 1 : 3][n][e] : dpp_from_next(acc[ai][hf][0][n][e]);
                    }
                    cv[hf] = w[hf][0] * p + w[hf][1] * acc[ai][hf][m][n] + w[hf][2] * q + bb[hf];
                }
                if (rl != 0 && rl != 63) {
                    float o[4];
#pragma unroll
                    for (int e = 0; e < 4; ++e) { const float a = cv[0][e]; o[e] = a * __builtin_amdgcn_rcpf(1.f + fexp(-a)) * cv[1][e]; }
                    u32x2 ww; ww.x = pk2(o[0], o[1]); ww.y = pk2(o[2], o[3]);
                    *(u32x2*)(act + (size_t)(row0 + rl) * DFF + jt + cl) = ww;
                }
                if (rl < 2 || rl > 61) {
                    const int hr = rl < 2 ? rl : rl - 60;
                    bf16_t* hp = halo + ((size_t)(row0 >> 6) * 4 + hr) * DUP + jt + cl;
#pragma unroll
                    for (int hf = 0; hf < 2; ++hf) { const f32x4 v = acc[ai][hf][m][n]; u32x2 ww; ww.x = pk2(v.x, v.y); ww.y = pk2(v.z, v.w); *(u32x2*)(hp + hf * DFF) = ww; }
                }
                __builtin_amdgcn_sched_barrier(0);
            }
        }
    }
}

DI void phase_glu_fixup(const bf16_t* __restrict__ halo, bf16_t* __restrict__ act, const float* __restrict__ cw, const float* __restrict__ cb) {
    const int gt = obid() * NTHREADS + otid();
    constexpr int NCG = DFF / 8;
    for (int unit = gt; unit < 512 * 2 * NCG; unit += ogdim() * NTHREADS) {
        const int cgp = unit % NCG, rs = unit / NCG, strip = rs >> 1, last = rs & 1, j0 = cgp * 8;
        const int t = strip * 64 + (last ? 63 : 0);
        const bool edge = last ? ((t & 8191) == 8191) : ((t & 8191) == 0);
        const bf16_t* hp = last ? halo + ((size_t)strip * 4 + 2) * DUP : (edge ? halo : halo + ((size_t)(strip - 1) * 4 + 3) * DUP);
        const bf16_t* hc = halo + ((size_t)strip * 4 + (last ? 3 : 0)) * DUP;
        const bf16_t* hn = last ? (edge ? halo : halo + ((size_t)(strip + 1) * 4 + 0) * DUP) : halo + ((size_t)strip * 4 + 1) * DUP;
        const bool zp = !last && edge, zn = last && edge;
        float res[8];
#pragma unroll
        for (int half = 0; half < 2; ++half) { (void)half; }
        u32x4 P[2], C[2], N[2];
#pragma unroll
        for (int hf = 0; hf < 2; ++hf) { P[hf] = *(const u32x4*)(hp + hf * DFF + j0); C[hf] = *(const u32x4*)(hc + hf * DFF + j0); N[hf] = *(const u32x4*)(hn + hf * DFF + j0); }
        float cvv[2][8];
#pragma unroll
        for (int hf = 0; hf < 2; ++hf) {
            const unsigned pw[4] = {P[hf].x, P[hf].y, P[hf].z, P[hf].w}, cwd[4] = {C[hf].x, C[hf].y, C[hf].z, C[hf].w}, nw[4] = {N[hf].x, N[hf].y, N[hf].z, N[hf].w};
#pragma unroll
            for (int e = 0; e < 8; ++e) {
                const float pv = zp ? 0.f : ((e & 1) ? bfhi(pw[e >> 1]) : bflo(pw[e >> 1]));
                const float cc = (e & 1) ? bfhi(cwd[e >> 1]) : bflo(cwd[e >> 1]);
                const float nv = zn ? 0.f : ((e & 1) ? bfhi(nw[e >> 1]) : bflo(nw[e >> 1]));
                const int col = hf * DFF + j0 + e;
                cvv[hf][e] = cw[col] * pv + cw[DUP + col] * cc + cw[2 * DUP + col] * nv + cb[col];
            }
        }
#pragma unroll
        for (int e = 0; e < 8; ++e) { const float a = cvv[0][e]; res[e] = a * __builtin_amdgcn_rcpf(1.f + fexp(-a)) * cvv[1][e]; }
        u32x4 o; o.x = pk2(res[0], res[1]); o.y = pk2(res[2], res[3]); o.z = pk2(res[4], res[5]); o.w = pk2(res[6], res[7]);
        *(u32x4*)(act + (size_t)t * DFF + j0) = o;
    }
}

template <int EPI>
DI void gemm_epilogue(f32x4 (&acc)[2][2][4][2], const EpiArgs& ea, int brow, int bcol, int wr, int wc, int fr_, int fq_) {
    int fr = fr_, fq = fq_;
    asm volatile("" : "+v"(fr), "+v"(fq));
    if (EPI == EPI_RESIDN) { epi_resid_norm(acc, ea.resid, ea.of, ea.hn, ea.gn, ea.ssqp, ea.cnt, brow, bcol, wr, wc, fr, fq); return; }
    if (EPI == EPI_RESID) { epi_resid(acc, ea.resid, ea.of, brow, bcol, wr, wc, fr, fq); return; }
    if (EPI == EPI_BF16) { epi_store_bf16(acc, ea.ob, ea.ldo, brow, bcol, wr, wc, fr, fq); return; }
    if (EPI == EPI_GLU) { epi_glu(acc, ea.ob, ea.halo, ea.cw, ea.cb, brow, bcol, wr, wc, fr, fq); return; }
    if (bcol >= 1024 && bcol < 1536) epi_store_vt(acc, ea.vt, brow, bcol, wr, wc, fr, fq);
    else {
        const int g = bcol >> 9, hb = (bcol >> 7) & 3, b = brow >> 13, s0 = brow & 8191;
        bf16_t* plane = ea.ob + pidx(g, b, hb, s0);
        if (bcol >= 2048 && bcol < 3072) epi_store_gate(acc, plane, ea.lb + (bcol - 2048), wr, wc, fr, fq);
        else epi_store_plane(acc, plane, wr, wc, fr, fq);
    }
}

template <int EPI>
DI void gemm_phase(const bf16_t* __restrict__ A, const bf16_t* __restrict__ Bt, int M, int N, int K, const EpiArgs& ea) {
    extern __shared__ __attribute__((aligned(16))) char shm[];
#define SA(b, h) (shm + ((b) * 2 + (h)) * 16384)
#define SB(b, h) (shm + (4 + (b) * 2 + (h)) * 16384)
#define STAGE(P, BASE, br, kt) do { const unsigned _g = (unsigned)(br) * (unsigned)K + (unsigned)(kt) * 64u; \
    __builtin_amdgcn_global_load_lds((const unsigned*)((BASE) + (_g + toff0)), (unsigned*)((P) + tid16), 16, 0, 0); \
    __builtin_amdgcn_global_load_lds((const unsigned*)((BASE) + (_g + toff1)), (unsigned*)((P) + tid16 + 8192), 16, 0, 0); } while (0)
#define STAGEB(P, BASE, br, kt) do { const unsigned _g = (unsigned)(br) * (unsigned)K + (unsigned)(kt) * 64u; \
    __builtin_amdgcn_global_load_lds((const unsigned*)((BASE) + (_g + toffb0)), (unsigned*)((P) + tid16), 16, 0, 0); \
    __builtin_amdgcn_global_load_lds((const unsigned*)((BASE) + (_g + toffb1)), (unsigned*)((P) + tid16 + 8192), 16, 0, 0); } while (0)
#define LDA(dst, b, h) _Pragma("unroll") for (int m = 0; m < 4; ++m) _Pragma("unroll") for (int k = 0; k < 2; ++k) \
    dst[m][k] = *reinterpret_cast<const bf16x8*>(SA(b, h) + lds_byte(wr * 64 + m * 16 + fr, k * 32 + fq * 8))
#define LDB(dst, b, h) _Pragma("unroll") for (int n = 0; n < 2; ++n) _Pragma("unroll") for (int k = 0; k < 2; ++k) \
    dst[n][k] = *reinterpret_cast<const bf16x8*>(SB(b, h) + lds_byte(wc * 32 + n * 16 + fr, k * 32 + fq * 8))
#define MMA(ai, bj, At, Bt_) do { __builtin_amdgcn_s_setprio(1); \
    _Pragma("unroll") for (int m = 0; m < 4; ++m) _Pragma("unroll") for (int n = 0; n < 2; ++n) _Pragma("unroll") for (int k = 0; k < 2; ++k) \
      acc[ai][bj][m][n] = __builtin_amdgcn_mfma_f32_16x16x32_bf16(Bt_[n][k], At[m][k], acc[ai][bj][m][n], 0, 0, 0); \
    __builtin_amdgcn_s_setprio(0); } while (0)
#define WAIT_V(n) asm volatile("s_waitcnt vmcnt(" #n ")" ::: "memory")
#define WAIT_L(n) asm volatile("s_waitcnt lgkmcnt(" #n ")" ::: "memory")
#define BAR __builtin_amdgcn_s_barrier()
#define SCHED __builtin_amdgcn_sched_barrier(0)
    const int nM = M / 256, nN = N / 256;
    const int nt = K / 64;
    int pm, pn;
    if (!tile_order(0, ogdim(), obid(), nM, nN, pm, pn)) return;
    int brow = pm * 256, bcol = pn * 256, nbrow = brow, nbcol = bcol;
    bool hn = tile_order(1, ogdim(), obid(), nM, nN, pm, pn);
    if (hn) { nbrow = pm * 256; nbcol = pn * 256; }
    const int tidx = otid();
    const int wid = __builtin_amdgcn_readfirstlane(tidx >> 6), lane = tidx & 63, wr = wid >> 2, wc = wid & 3, fr = lane & 15, fq = lane >> 4;
    const int tid16 = tidx * 16;
    unsigned toff0, toff1;
    unsigned toffb0, toffb1;
    { int r_, c_; stage_rc(tid16, r_, c_); const int ra0 = EPI == EPI_GLU ? (r_ & ~63) + 4 * (r_ & 15) + ((r_ >> 4) & 3) : r_;
      toff0 = (unsigned)(ra0 * K + c_); toffb0 = (unsigned)(((r_ & ~31) + perm32(r_ & 31)) * K + c_);
      stage_rc(tid16 + 8192, r_, c_); const int ra1 = EPI == EPI_GLU ? (r_ & ~63) + 4 * (r_ & 15) + ((r_ >> 4) & 3) : r_;
      toff1 = (unsigned)(ra1 * K + c_); toffb1 = (unsigned)(((r_ & ~31) + perm32(r_ & 31)) * K + c_); }
    f32x4 acc[2][2][4][2];
#pragma unroll
    for (int a = 0; a < 2; ++a)
#pragma unroll
        for (int b = 0; b < 2; ++b)
#pragma unroll
            for (int c = 0; c < 4; ++c)
#pragma unroll
                for (int d = 0; d < 2; ++d) acc[a][b][c][d] = (f32x4){0.f, 0.f, 0.f, 0.f};
    bf16x8 At[4][2], B0[2][2], B1[2][2];
    STAGEB(SB(0, 0), Bt, bcol, 0); STAGEB(SB(0, 1), Bt, bcol + 128, 0); STAGE(SA(0, 0), A, brow, 0); STAGE(SA(0, 1), A, brow + 128, 0);
    if (wr == 1) BAR;
    WAIT_V(2); BAR;
    STAGEB(SB(1, 0), Bt, bcol, 1); STAGE(SA(1, 0), A, brow, 1); STAGEB(SB(1, 1), Bt, bcol + 128, 1);
    WAIT_V(6); BAR;
#pragma unroll 1
    for (int it = 0;; ++it) {
#pragma unroll 1
        for (int t = 0; t < nt; t += 2) {
            const bool wrap = (t + 2 >= nt);
            const int r2 = wrap ? nbrow : brow, c2 = wrap ? nbcol : bcol, k2 = wrap ? 0 : t + 2, k3 = k2 + 1;
            LDB(B0, 0, 0); LDB(B1, 0, 1); SCHED; LDA(At, 0, 0); STAGE(SA(1, 1), A, brow + 128, t + 1);
            WAIT_V(8); WAIT_L(0); BAR; MMA(0, 0, At, B0); MMA(0, 1, At, B1); BAR; SCHED;
            LDA(At, 0, 1); STAGEB(SB(0, 0), Bt, c2, k2); STAGEB(SB(0, 1), Bt, c2 + 128, k2); STAGE(SA(0, 0), A, r2, k2);
            WAIT_V(8); WAIT_L(0); BAR; MMA(1, 0, At, B0); MMA(1, 1, At, B1); BAR; SCHED;
            LDB(B0, 1, 0); LDB(B1, 1, 1); SCHED; LDA(At, 1, 0); STAGE(SA(0, 1), A, r2 + 128, k2);
            WAIT_V(8); WAIT_L(0); BAR; MMA(0, 0, At, B0); MMA(0, 1, At, B1); BAR; SCHED;
            LDA(At, 1, 1); STAGEB(SB(1, 0), Bt, c2, k3); STAGEB(SB(1, 1), Bt, c2 + 128, k3); STAGE(SA(1, 0), A, r2, k3);
            WAIT_V(8); WAIT_L(0); BAR; MMA(1, 0, At, B0); MMA(1, 1, At, B1); BAR; SCHED;
        }
        if (wr == 0) BAR;
        gemm_epilogue<EPI>(acc, ea, brow, bcol, wr, wc, fr, fq);
        if (!hn) break;
#pragma unroll
        for (int a = 0; a < 2; ++a)
#pragma unroll
            for (int b = 0; b < 2; ++b)
#pragma unroll
                for (int c = 0; c < 4; ++c)
#pragma unroll
                    for (int d = 0; d < 2; ++d) acc[a][b][c][d] = (f32x4){0.f, 0.f, 0.f, 0.f};
        brow = nbrow; bcol = nbcol;
        hn = tile_order(it + 2, ogdim(), obid(), nM, nN, pm, pn);
        if (hn) { nbrow = pm * 256; nbcol = pn * 256; }
        if (wr == 1) BAR;
    }
    WAIT_V(0);
    __syncthreads();
#undef SA
#undef SB
#undef STAGE
#undef STAGEB
#undef LDA
#undef LDB
#undef MMA
}

DI void phase_qkprep(bf16_t* proj, const float* __restrict__ rope, const float* __restrict__ kg) {
    const int tid = otid(), wave = tid >> 6, lane = tid & 63;
    const int grp = lane >> 2, tsel = grp >> 3, hc = grp & 7, qq = lane & 3;
    float g1[8], g2[8];
#pragma unroll
    for (int e = 0; e < 8; ++e) { g1[e] = kg[qq * 8 + e]; g2[e] = kg[32 + qq * 8 + e]; }
    for (int t0 = (obid() * NWAVES + wave) * 8; t0 < T_; t0 += ogdim() * NWAVES * 8) {
        u32x4 r1[4], r2[4]; f32x4 c0[4], c1[4], s0[4], s1[4];
#pragma unroll
        for (int u = 0; u < 4; ++u) {
            const int t = t0 + 2 * u + tsel;
            const bf16_t* pp = proj + pidx(1, t >> 13, hc >> 1, t & 8191) + (hc & 1) * 64 + qq * 8;
            r1[u] = *(const u32x4*)pp; r2[u] = *(const u32x4*)(pp + 32);
            const float* rp = rope + (size_t)t * 64 + qq * 8;
            c0[u] = *(const f32x4*)rp; c1[u] = *(const f32x4*)(rp + 4); s0[u] = *(const f32x4*)(rp + 32); s1[u] = *(const f32x4*)(rp + 36);
        }
#pragma unroll
        for (int u = 0; u < 4; ++u) {
            const int t = t0 + 2 * u + tsel;
            bf16_t* pp = proj + pidx(1, t >> 13, hc >> 1, t & 8191) + (hc & 1) * 64 + qq * 8;
            float x1[8], x2[8];
            x1[0] = bflo(r1[u].x); x1[1] = bfhi(r1[u].x); x1[2] = bflo(r1[u].y); x1[3] = bfhi(r1[u].y); x1[4] = bflo(r1[u].z); x1[5] = bfhi(r1[u].z); x1[6] = bflo(r1[u].w); x1[7] = bfhi(r1[u].w);
            x2[0] = bflo(r2[u].x); x2[1] = bfhi(r2[u].x); x2[2] = bflo(r2[u].y); x2[3] = bfhi(r2[u].y); x2[4] = bflo(r2[u].z); x2[5] = bfhi(r2[u].z); x2[6] = bflo(r2[u].w); x2[7] = bfhi(r2[u].w);
            float ss = 0.f;
#pragma unroll
            for (int e = 0; e < 8; ++e) ss += x1[e] * x1[e] + x2[e] * x2[e];
            ss += shx(ss, 1); ss += shx(ss, 2);
            const float rstd = 1.0f / sqrtf(ss * (1.f / 64.f) + EPS);
            const float cs[8] = {c0[u].x, c0[u].y, c0[u].z, c0[u].w, c1[u].x, c1[u].y, c1[u].z, c1[u].w}, sn[8] = {s0[u].x, s0[u].y, s0[u].z, s0[u].w, s1[u].x, s1[u].y, s1[u].z, s1[u].w};
            float y1[8], y2[8];
#pragma unroll
            for (int e = 0; e < 8; ++e) {
                const float a = x1[e] * rstd * g1[e], bq = x2[e] * rstd * g2[e];
                y1[e] = a * cs[e] - bq * sn[e]; y2[e] = bq * cs[e] + a * sn[e];
            }
            u32x4 o1, o2;
            o1.x = pk2(y1[0], y1[1]); o1.y = pk2(y1[2], y1[3]); o1.z = pk2(y1[4], y1[5]); o1.w = pk2(y1[6], y1[7]);
            o2.x = pk2(y2[0], y2[1]); o2.y = pk2(y2[2], y2[3]); o2.z = pk2(y2[4], y2[5]); o2.w = pk2(y2[6], y2[7]);
            *(u32x4*)pp = o1; *(u32x4*)(pp + 32) = o2;
        }
    }
}

constexpr int KS_BYTES = 64 * 256, VS_BYTES = 128 * 128, KV_BYTES = KS_BYTES + VS_BYTES;

template <bool SHIFT>
DI void phase_attention(const bf16_t* proj, const bf16_t* vt, bf16_t* y, const float* dog, float lam, float oscale, float mb, const float* __restrict__ rope, const float* __restrict__ qgn) {
    extern __shared__ __attribute__((aligned(16))) char shm[];
#pragma unroll 1
    for (int item = obid(); item < NB * 4 * 32; item += ogdim()) {
        const int tid = otid();
        const int wave = __builtin_amdgcn_readfirstlane(tid >> 6), lane = tid & 63, r = lane & 31, hh = lane >> 5;
        const int c = wave & 1, qg = wave >> 1;
        const int pair = ((item >> 8) << 3) | (item & 7), qb = (item >> 3) & 31, b = pair >> 2, h = pair & 3;
        const int q0 = qb * 256 + qg * 64;
        bf16x8 qf[2][4];
#pragma unroll
        for (int blk = 0; blk < 2; ++blk)
#pragma unroll
            for (int ks = 0; ks < 4; ++ks) qf[blk][ks] = *(const bf16x8*)(proj + (unsigned)(pidx(0, b, h, q0 + blk * 32 + r) + c * 64 + ks * 16 + hh * 8));
#pragma unroll
        for (int blk = 0; blk < 2; ++blk) {
            float x[4][8]; float ss = 0.f;
#pragma unroll
            for (int ks = 0; ks < 4; ++ks) {
                const u32x4 w = __builtin_bit_cast(u32x4, qf[blk][ks]);
                x[ks][0] = bflo(w.x); x[ks][1] = bfhi(w.x); x[ks][2] = bflo(w.y); x[ks][3] = bfhi(w.y); x[ks][4] = bflo(w.z); x[ks][5] = bfhi(w.z); x[ks][6] = bflo(w.w); x[ks][7] = bfhi(w.w);
#pragma unroll
                for (int e = 0; e < 8; ++e) ss += x[ks][e] * x[ks][e];
            }
            ss += shx(ss, 32);
            const float rstd = 1.0f / sqrtf(ss * (1.f / 64.f) + EPS);
            const float* rp = rope + (size_t)(b * S_ + q0 + blk * 32 + r) * 64 + hh * 8;
#pragma unroll
            for (int ks = 0; ks < 2; ++ks) {
                const f32x4 ca = *(const f32x4*)(rp + ks * 16), cb2 = *(const f32x4*)(rp + ks * 16 + 4), sa = *(const f32x4*)(rp + 32 + ks * 16), sb2 = *(const f32x4*)(rp + 32 + ks * 16 + 4);
                const f32x4 ga = *(const f32x4*)(qgn + ks * 16 + hh * 8), gb = *(const f32x4*)(qgn + ks * 16 + hh * 8 + 4), gc = *(const f32x4*)(qgn + 32 + ks * 16 + hh * 8), gd = *(const f32x4*)(qgn + 32 + ks * 16 + hh * 8 + 4);
                const float cs[8] = {ca.x, ca.y, ca.z, ca.w, cb2.x, cb2.y, cb2.z, cb2.w}, sn[8] = {sa.x, sa.y, sa.z, sa.w, sb2.x, sb2.y, sb2.z, sb2.w};
                const float g1[8] = {ga.x, ga.y, ga.z, ga.w, gb.x, gb.y, gb.z, gb.w}, g2[8] = {gc.x, gc.y, gc.z, gc.w, gd.x, gd.y, gd.z, gd.w};
                float y1[8], y2[8];
#pragma unroll
                for (int e = 0; e < 8; ++e) {
                    const float a = x[ks][e] * rstd * g1[e], bq = x[ks + 2][e] * rstd * g2[e];
                    y1[e] = (a * cs[e] - bq * sn[e]) * (0.125f * LOG2E); y2[e] = (bq * cs[e] + a * sn[e]) * (0.125f * LOG2E);
                }
                qf[blk][ks] = pack8(y1[0], y1[1], y1[2], y1[3], y1[4], y1[5], y1[6], y1[7]);
                qf[blk][ks + 2] = pack8(y2[0], y2[1], y2[2], y2[3], y2[4], y2[5], y2[6], y2[7]);
            }
        }
        f32x16 O[2][4];
#pragma unroll
        for (int blk = 0; blk < 2; ++blk)
#pragma unroll
            for (int vb = 0; vb < 4; ++vb)
#pragma unroll
                for (int i = 0; i < 16; ++i) O[blk][vb][i] = 0.f;
        float lsum[2] = {0.f, 0.f};
        unsigned ko0, ko1, vo0, vo1;
        {
            const int L0 = (2 * wave) * 64 + lane, L1 = L0 + 64;
            const int r0 = L0 >> 4, c0 = (L0 & 15) ^ (r0 & 15), r1 = L1 >> 4, c1 = (L1 & 15) ^ (r1 & 15);
            const int s0 = (r0 & ~12) | ((r0 & 4) << 1) | ((r0 & 8) >> 1), s1 = (r1 & ~12) | ((r1 & 4) << 1) | ((r1 & 8) >> 1);
            ko0 = (unsigned)(pidx(1, b, h, s0) + c0 * 8);
            ko1 = (unsigned)(pidx(1, b, h, s1) + c1 * 8);
            const int v0 = L0 >> 3, d0 = (L0 & 7) ^ ((v0 >> 1) & 7), v1 = L1 >> 3, d1 = (L1 & 7) ^ ((v1 >> 1) & 7);
            vo0 = (unsigned)(((b * 4 + h) * 128 + v0) * S_ + d0 * 8);
            vo1 = (unsigned)(((b * 4 + h) * 128 + v1) * S_ + d1 * 8);
        }
#define LOADKV(kt, buf) do { char* kb_ = shm + (buf) * KV_BYTES + (2 * wave) * 1024; char* vb_ = shm + (buf) * KV_BYTES + KS_BYTES + (2 * wave) * 1024; \
            __builtin_amdgcn_global_load_lds((const unsigned*)(proj + (ko0 + (unsigned)(kt) * (64u * 128u))), (unsigned*)(kb_), 16, 0, 0); \
            __builtin_amdgcn_global_load_lds((const unsigned*)(proj + (ko1 + (unsigned)(kt) * (64u * 128u))), (unsigned*)(kb_ + 1024), 16, 0, 0); \
            __builtin_amdgcn_global_load_lds((const unsigned*)(vt + (vo0 + (unsigned)(kt) * 64u)), (unsigned*)(vb_), 16, 0, 0); \
            __builtin_amdgcn_global_load_lds((const unsigned*)(vt + (vo1 + (unsigned)(kt) * 64u)), (unsigned*)(vb_ + 1024), 16, 0, 0); } while (0)
        __syncthreads();
        LOADKV(0, 0);
        asm volatile("s_waitcnt vmcnt(0)" ::: "memory");
        __syncthreads();
        constexpr int NT = S_ / 64;
#pragma unroll 1
        for (int kt = 0; kt < NT; ++kt) {
            if (kt + 1 < NT) LOADKV(kt + 1, (kt + 1) & 1);
            const char* ksb = shm + (kt & 1) * KV_BYTES; const char* vsb = ksb + KS_BYTES;
#pragma unroll 1
            for (int kb = 0; kb < 2; ++kb) {
                bf16x8 P[2][2];
                const int rho = kb * 32 + r;
                const char* krow_p = ksb + rho * 256 + c * 128;
                int ksw = r & 15, vsw = (r >> 1) & 7;
                asm volatile("" : "+v"(ksw), "+v"(vsw));
                bf16x8 kf[4];
#pragma unroll
                for (int ks = 0; ks < 4; ++ks) kf[ks] = *(const bf16x8*)(ksb + rho * 256 + (((c * 8 + ks * 2 + hh) ^ ksw) * 16));
                (void)krow_p;
                f32x16 X0, X1;
#pragma unroll
                for (int i = 0; i < 16; ++i) { X0[i] = 0.f; X1[i] = 0.f; }
#pragma unroll
                for (int ks = 0; ks < 4; ++ks) { X0 = MFMA32(kf[ks], qf[0][ks], X0); X1 = MFMA32(kf[ks], qf[1][ks], X1); }
                __builtin_amdgcn_sched_barrier(0);
                bf16x8 va[2][2];
                { const char* vrow_p = vsb + r * 128;
                  va[0][0] = *(const bf16x8*)(vrow_p + (((kb * 4 + hh) ^ vsw) * 16));
                  va[0][1] = *(const bf16x8*)(vrow_p + (((kb * 4 + 2 + hh) ^ vsw) * 16)); }
                {
                    float ps = 0.f;
#pragma unroll
                    for (int i = 0; i < 16; ++i) { X0[i] = __builtin_amdgcn_exp2f(SHIFT ? X0[i] - mb : X0[i]); ps += X0[i]; }
                    lsum[0] += ps;
                    { const char* vrow_p = vsb + (32 + r) * 128;
                      va[1][0] = *(const bf16x8*)(vrow_p + (((kb * 4 + hh) ^ vsw) * 16));
                      va[1][1] = *(const bf16x8*)(vrow_p + (((kb * 4 + 2 + hh) ^ vsw) * 16)); }
                    P[0][0] = pack8(X0[0], X0[1], X0[2], X0[3], X0[4], X0[5], X0[6], X0[7]);
                    P[0][1] = pack8(X0[8], X0[9], X0[10], X0[11], X0[12], X0[13], X0[14], X0[15]);
                }
                __builtin_amdgcn_sched_barrier(0);
#pragma unroll
                for (int vb = 0; vb < 2; ++vb) { O[0][vb] = MFMA32(P[0][0], va[vb][0], O[0][vb]); O[0][vb] = MFMA32(P[0][1], va[vb][1], O[0][vb]); }
                bf16x8 vc0, vc1;
                {
                    float ps = 0.f;
#pragma unroll
                    for (int i = 0; i < 16; ++i) { X1[i] = __builtin_amdgcn_exp2f(SHIFT ? X1[i] - mb : X1[i]); ps += X1[i]; }
                    lsum[1] += ps;
                    vc0 = *(const bf16x8*)(vsb + (64 + r) * 128 + (((kb * 4 + hh) ^ vsw) * 16));
                    vc1 = *(const bf16x8*)(vsb + (64 + r) * 128 + (((kb * 4 + 2 + hh) ^ vsw) * 16));
                    P[1][0] = pack8(X1[0], X1[1], X1[2], X1[3], X1[4], X1[5], X1[6], X1[7]);
                    P[1][1] = pack8(X1[8], X1[9], X1[10], X1[11], X1[12], X1[13], X1[14], X1[15]);
                }
                __builtin_amdgcn_sched_barrier(0);
#pragma unroll
                for (int vb = 0; vb < 2; ++vb) { O[1][vb] = MFMA32(P[1][0], va[vb][0], O[1][vb]); O[1][vb] = MFMA32(P[1][1], va[vb][1], O[1][vb]); }
                __builtin_amdgcn_sched_barrier(0);
                const bf16x8 vd0 = *(const bf16x8*)(vsb + (96 + r) * 128 + (((kb * 4 + hh) ^ vsw) * 16));
                const bf16x8 vd1 = *(const bf16x8*)(vsb + (96 + r) * 128 + (((kb * 4 + 2 + hh) ^ vsw) * 16));
                O[0][2] = MFMA32(P[0][0], vc0, O[0][2]); O[1][2] = MFMA32(P[1][0], vc0, O[1][2]);
                O[0][2] = MFMA32(P[0][1], vc1, O[0][2]); O[1][2] = MFMA32(P[1][1], vc1, O[1][2]);
                __builtin_amdgcn_sched_barrier(0);
                O[0][3] = MFMA32(P[0][0], vd0, O[0][3]); O[1][3] = MFMA32(P[1][0], vd0, O[1][3]);
                O[0][3] = MFMA32(P[0][1], vd1, O[0][3]); O[1][3] = MFMA32(P[1][1], vd1, O[1][3]);
                __builtin_amdgcn_sched_barrier(0);
            }
            asm volatile("s_waitcnt vmcnt(0) lgkmcnt(0)" ::: "memory");
            __builtin_amdgcn_s_barrier();
            asm volatile("" ::: "memory");
        }
#undef LOADKV
        float linv[2];
#pragma unroll
        for (int blk = 0; blk < 2; ++blk) { const float l = lsum[blk] + shx(lsum[blk], 32); linv[blk] = 1.0f / l; }
        float* xch = (float*)shm + qg * (2 * 4 * 16 * 64) + lane;
#pragma unroll
        for (int blk = 0; blk < 2; ++blk)
#pragma unroll
            for (int i = 0; i < 16; ++i) {
                const float li = shl_(linv[blk], crow(i, hh));
#pragma unroll
                for (int vb = 0; vb < 4; ++vb) O[blk][vb][i] *= li;
            }
        if (c == 1) {
#pragma unroll
            for (int blk = 0; blk < 2; ++blk)
#pragma unroll
                for (int vb = 0; vb < 4; ++vb)
#pragma unroll
                    for (int i = 0; i < 16; ++i) xch[((blk * 4 + vb) * 16 + i) * 64] = O[blk][vb][i];
        }
        __syncthreads();
        if (c == 0) {
            float gv4[4];
#pragma unroll
            for (int vb = 0; vb < 4; ++vb) gv4[vb] = dog[vb * 32 + r] * oscale;
#pragma unroll
            for (int blk = 0; blk < 2; ++blk)
#pragma unroll
                for (int i = 0; i < 16; ++i) {
                    const int qrow = crow(i, hh);
                    float o[4], ss = 0.f;
#pragma unroll
                    for (int vb = 0; vb < 4; ++vb) { o[vb] = O[blk][vb][i] - lam * xch[((blk * 4 + vb) * 16 + i) * 64]; ss += o[vb] * o[vb]; }
                    ss += shx(ss, 1); ss += shx(ss, 2); ss += shx(ss, 4); ss += shx(ss, 8); ss += shx(ss, 16);
                    const float rstd = 1.0f / sqrtf(ss * (1.f / 128.f) + EPS);
                    const unsigned yo = (unsigned)((b * S_ + q0 + blk * 32 + qrow) * D_ + h * 128 + r);
#pragma unroll
                    for (int vb = 0; vb < 4; ++vb) y[yo + vb * 32] = f2bf(o[vb] * rstd * gv4[vb]);
                }
        }
    }
}

constexpr int REL_STRIDE = 132;
constexpr int HL_REL = 0;
constexpr int HL_K = 67584;
constexpr int HL_VT = HL_K + 34816;
constexpr int HL_SEG = HL_VT + 34816;
constexpr int HL_SSQ = HL_SEG + 2048;
constexpr int HROW = 272;

template <int MODE>
DI void hgrn_cumsum(const bf16_t* proj, const float* lb, int dir, int b, int h, int m, char* shm, float* dec_out) {
    const int tid = otid(), d = tid & 127, seg = tid >> 7;
    const bf16_t* zp = proj + pidx(4 + dir, b, h, m * 128 + seg * 32) + d;
    float c[32], kv[32];
#pragma unroll
    for (int i = 0; i < 32; ++i) {
        const float lf = bf2f(zp[i * 128]);
        c[i] = lf; kv[i] = 1.f - fexp(lf);
    }
    if (dir == 0) {
#pragma unroll
        for (int i = 1; i < 32; ++i) c[i] += c[i - 1];
    } else {
#pragma unroll
        for (int i = 30; i >= 0; --i) c[i] += c[i + 1];
    }
    float* segtot = (float*)(shm + HL_SEG);
    segtot[seg * 128 + d] = (dir == 0) ? c[31] : c[0];
    __syncthreads();
    const float t0 = segtot[d], t1 = segtot[128 + d], t2 = segtot[256 + d], t3 = segtot[384 + d];
    float off;
    if (dir == 0) off = (seg > 0 ? t0 : 0.f) + (seg > 1 ? t1 : 0.f) + (seg > 2 ? t2 : 0.f);
    else off = (seg < 3 ? t3 : 0.f) + (seg < 2 ? t2 : 0.f) + (seg < 1 ? t1 : 0.f);
    if (MODE == 0) {
        const float total = (t0 + t1) + (t2 + t3);
        if (seg == 0) dec_out[d] = expf(total);
        char* kt = shm + HL_K + d * HROW + seg * 64;
#pragma unroll
        for (int i = 0; i < 32; i += 8) {
            float e[8];
#pragma unroll
            for (int j = 0; j < 8; ++j) e[j] = kv[i + j] * fexp(total - (c[i + j] + off));
            *(bf16x8*)(kt + i * 2) = pack8(e[0], e[1], e[2], e[3], e[4], e[5], e[6], e[7]);
        }
    } else {
        float* rel = (float*)(shm + HL_REL);
        bf16_t* kl = (bf16_t*)(shm + HL_K);
#pragma unroll
        for (int i = 0; i < 32; ++i) {
            const int t = seg * 32 + i;
            rel[t * REL_STRIDE + d] = c[i] + off;
            kl[t * (HROW / 2) + d] = f2bf(kv[i]);
        }
    }
}

DI void hgrn_load_vt(const bf16_t* proj, int b, int h, int m, char* shm) {
    const int tid = otid(), s = tid & 127, vg = tid >> 7;
    const bf16_t* ip = proj + pidx(6, b, h, m * 128 + s) + vg * 32;
    bf16_t* vtl = (bf16_t*)(shm + HL_VT);
#pragma unroll
    for (int j = 0; j < 4; ++j) {
        const u32x4 w = *(const u32x4*)(ip + j * 8);
        const unsigned ww[4] = {w.x, w.y, w.z, w.w};
#pragma unroll
        for (int e = 0; e < 4; ++e) {
            const int v = vg * 32 + j * 8 + e * 2;
            vtl[v * (HROW / 2) + s] = (bf16_t)(ww[e] & 0xffffu);
            vtl[(v + 1) * (HROW / 2) + s] = (bf16_t)(ww[e] >> 16);
        }
    }
}

DI void phase_hgrn_pass1(const bf16_t* __restrict__ proj, const float* __restrict__ lb, bf16_t* __restrict__ states, float* __restrict__ dec) {
    extern __shared__ __attribute__((aligned(16))) char shm[];
    constexpr int P1_K1 = HL_REL, P1_SEG = HL_REL + 40960;
#pragma unroll 1
    for (int item = obid(); item < NB * 4 * 64; item += ogdim()) {
        const int tid = otid(), wave = __builtin_amdgcn_readfirstlane(tid >> 6), lane = tid & 63, r = lane & 31, hh = lane >> 5;
        const int b = item >> 8, h = (item >> 6) & 3, m = item & 63;
        const int d = tid & 127, seg = tid >> 7;
        __syncthreads();
        hgrn_load_vt(proj, b, h, m, shm);
        float c0[32], c1[32];
        {
            const bf16_t* z0 = proj + pidx(4, b, h, m * 128 + seg * 32) + d;
            const bf16_t* z1 = proj + pidx(5, b, h, m * 128 + seg * 32) + d;
#pragma unroll
            for (int i = 0; i < 32; ++i) { c0[i] = bf2f(z0[i * 128]); c1[i] = bf2f(z1[i * 128]); }
        }
        float* segtot = (float*)(shm + P1_SEG);
        {
            float s0 = 0.f, s1 = 0.f;
#pragma unroll
            for (int i = 0; i < 32; ++i) { s0 += c0[i]; s1 += c1[i]; }
            segtot[seg * 128 + d] = s0; segtot[512 + seg * 128 + d] = s1;
        }
        __syncthreads();
        {
            const float a0 = segtot[d], a1 = segtot[128 + d], a2 = segtot[256 + d], a3 = segtot[384 + d];
            const float e0 = segtot[512 + d], e1 = segtot[640 + d], e2 = segtot[768 + d], e3 = segtot[896 + d];
            float run0 = (seg < 3 ? a3 : 0.f) + (seg < 2 ? a2 : 0.f) + (seg < 1 ? a1 : 0.f);
            float run1 = (seg > 0 ? e0 : 0.f) + (seg > 1 ? e1 : 0.f) + (seg > 2 ? e2 : 0.f);
            if (seg == 0) {
                const int s0i = ((0 * 4 + b) * 4 + h) * 64 + m, s1i = ((1 * 4 + b) * 4 + h) * 64 + m;
                dec[(size_t)s0i * 128 + d] = expf((a0 + a1) + (a2 + a3));
                dec[(size_t)s1i * 128 + d] = expf((e0 + e1) + (e2 + e3));
            }
            float k0[32], k1[32];
            float p0 = fexp(run0), p1 = fexp(run1);
#pragma unroll
            for (int i = 31; i >= 0; --i) { const float fi = fexp(c0[i]); k0[i] = (1.f - fi) * p0; p0 *= fi; }
#pragma unroll
            for (int i = 0; i < 32; ++i) { const float fi = fexp(c1[i]); k1[i] = (1.f - fi) * p1; p1 *= fi; }
            char* kt0 = shm + HL_K + d * HROW + seg * 64;
            char* kt1 = shm + P1_K1 + d * HROW + seg * 64;
#pragma unroll
            for (int i = 0; i < 32; i += 8) {
                *(bf16x8*)(kt0 + i * 2) = pack8(k0[i], k0[i + 1], k0[i + 2], k0[i + 3], k0[i + 4], k0[i + 5], k0[i + 6], k0[i + 7]);
                *(bf16x8*)(kt1 + i * 2) = pack8(k1[i], k1[i + 1], k1[i + 2], k1[i + 3], k1[i + 4], k1[i + 5], k1[i + 6], k1[i + 7]);
            }
        }
        __syncthreads();
        {
            const int dir = wave >> 2, vblk = wave & 3;
            const char* kbase = shm + (dir ? P1_K1 : HL_K);
            f32x16 L[4];
#pragma unroll
            for (int j = 0; j < 4; ++j)
#pragma unroll
                for (int i = 0; i < 16; ++i) L[j][i] = 0.f;
#pragma unroll
            for (int ks = 0; ks < 8; ++ks) {
                const bf16x8 af = *(const bf16x8*)(shm + HL_VT + (vblk * 32 + r) * HROW + (ks * 16 + hh * 8) * 2);
#pragma unroll
                for (int j = 0; j < 4; ++j) {
                    const bf16x8 bf = *(const bf16x8*)(kbase + (j * 32 + r) * HROW + (ks * 16 + hh * 8) * 2);
                    L[j] = MFMA32(af, bf, L[j]);
                }
            }
            const int sidx = ((dir * 4 + b) * 4 + h) * 64 + m;
            bf16_t* sp = states + (size_t)sidx * 16384;
#pragma unroll
            for (int j = 0; j < 4; ++j)
#pragma unroll
                for (int i = 0; i < 16; ++i) sp[(vblk * 32 + crow(i, hh)) * 128 + j * 32 + r] = f2bf(L[j][i]);
        }
    }
}

DI void phase_hgrn_scan(bf16_t* states, const float* __restrict__ dec) {
    const int gt = obid() * NTHREADS + otid();
    for (int u = gt; u < 32 * 4096; u += ogdim() * NTHREADS) {
        const int chain = u >> 12, e4 = u & 4095, dir = chain >> 4;
        const int d0 = (e4 * 4) & 127;
        bf16_t* sp = states + (size_t)chain * 64 * 16384 + e4 * 4;
        const float* dp = dec + (size_t)chain * 64 * 128 + d0;
        float c0 = 0.f, c1 = 0.f, c2 = 0.f, c3 = 0.f;
#pragma unroll 1
        for (int mb = 0; mb < 64; mb += 16) {
            u32x2 w[16]; f32x4 dv[16];
#pragma unroll
            for (int k = 0; k < 16; ++k) { const int m = dir ? 63 - (mb + k) : mb + k; w[k] = *(const u32x2*)(sp + (size_t)m * 16384); dv[k] = *(const f32x4*)(dp + m * 128); }
#pragma unroll
            for (int k = 0; k < 16; ++k) {
                const int m = dir ? 63 - (mb + k) : mb + k;
                u32x2 o; o.x = pk2(c0, c1); o.y = pk2(c2, c3);
                *(u32x2*)(sp + (size_t)m * 16384) = o;
                c0 = dv[k].x * c0 + bflo(w[k].x); c1 = dv[k].y * c1 + bfhi(w[k].x); c2 = dv[k].z * c2 + bflo(w[k].y); c3 = dv[k].w * c3 + bfhi(w[k].y);
            }
        }
    }
}

constexpr int H3_QH = 0, H3_KC = 34816, H3_KHT = 69632, H3_VT = 104448, H3_GDEC = 139264, H3_SSQ = 141312;
#define MFMA16(a, b, c) __builtin_amdgcn_mfma_f32_16x16x32_bf16((a), (b), (c), 0, 0, 0)
DI bf16x8 ld2x8(const char* p, int second_off) { const u32x2 lo = *(const u32x2*)p, hi = *(const u32x2*)(p + second_off); u32x4 w; w.x = lo.x; w.y = lo.y; w.z = hi.x; w.w = hi.y; return __builtin_bit_cast(bf16x8, w); }

DI void hgrn3_stage(const bf16_t* proj, const float* lb, int dir, int b, int h, int m, char* shm, const float (&qv)[32]) {
    const int tid = otid(), d = tid & 127, seg = tid >> 7;
    const bf16_t* zp = proj + pidx(4 + dir, b, h, m * 128 + seg * 32) + d;
    float f[32], ec[32];
#pragma unroll
    for (int i = 0; i < 32; ++i) f[i] = fexp(bf2f(zp[i * 128]));
    if (dir == 0) {
        ec[0] = f[0];
#pragma unroll
        for (int i = 1; i < 32; ++i) ec[i] = ec[i - 1] * f[i];
    } else {
        ec[31] = f[31];
#pragma unroll
        for (int i = 30; i >= 0; --i) ec[i] = ec[i + 1] * f[i];
    }
    ((float*)(shm + H3_GDEC))[seg * 128 + d] = dir == 0 ? ec[31] : ec[0];
    bf16_t* qh = (bf16_t*)(shm + H3_QH); bf16_t* kc = (bf16_t*)(shm + H3_KC);
#pragma unroll
    for (int i = 0; i < 32; ++i) {
        const int t = seg * 32 + i;
        qh[t * 136 + d] = f2bf(qv[i] * ec[i]);
        kc[t * 136 + d] = f2bf((1.f - f[i]) * fminf(__builtin_amdgcn_rcpf(ec[i]), 1e30f));
    }
    float rem = 1.f;
    if (dir == 0) {
#pragma unroll
        for (int i = 31; i >= 0; --i) { const float fi = f[i]; ec[i] = (1.f - fi) * rem; rem *= fi; }
    } else {
#pragma unroll
        for (int i = 0; i < 32; ++i) { const float fi = f[i]; ec[i] = (1.f - fi) * rem; rem *= fi; }
    }
    char* kt = shm + H3_KHT + d * HROW + seg * 64;
#pragma unroll
    for (int i = 0; i < 32; i += 8)
        *(bf16x8*)(kt + i * 2) = pack8(ec[i], ec[i + 1], ec[i + 2], ec[i + 3], ec[i + 4], ec[i + 5], ec[i + 6], ec[i + 7]);
}

template <int DIR>
DI void hgrn3_mma(const char* shm, f32x4 (&S)[8], f32x4 (&O)[4][2], int v0, int j, int q4) {
#pragma unroll
    for (int step = 0; step < 4; ++step) {
        const int I = DIR == 0 ? step : 3 - step;
        {
            bf16x8 sb[4];
#pragma unroll
            for (int a = 0; a < 4; ++a) sb[a] = pack8(S[2 * a][0], S[2 * a][1], S[2 * a][2], S[2 * a][3], S[2 * a + 1][0], S[2 * a + 1][1], S[2 * a + 1][2], S[2 * a + 1][3]);
#pragma unroll
            for (int tt = 0; tt < 2; ++tt)
#pragma unroll
                for (int a = 0; a < 4; ++a) {
                    const bf16x8 af = ld2x8(shm + H3_QH + (32 * I + 16 * tt + j) * HROW + (32 * a + 4 * q4) * 2, 32);
                    O[I][tt] = MFMA16(af, sb[a], O[I][tt]);
                }
        }
        {
            f32x4 XT[2][2];
#pragma unroll
            for (int st = 0; st < 2; ++st)
#pragma unroll
                for (int tt = 0; tt < 2; ++tt) XT[st][tt] = (f32x4){0.f, 0.f, 0.f, 0.f};
#pragma unroll
            for (int ks = 0; ks < 4; ++ks) {
                bf16x8 kf[2], qf[2];
#pragma unroll
                for (int st = 0; st < 2; ++st) kf[st] = *(const bf16x8*)(shm + H3_KC + (32 * I + 16 * st + j) * HROW + (32 * ks + 8 * q4) * 2);
#pragma unroll
                for (int tt = 0; tt < 2; ++tt) qf[tt] = *(const bf16x8*)(shm + H3_QH + (32 * I + 16 * tt + j) * HROW + (32 * ks + 8 * q4) * 2);
#pragma unroll
                for (int st = 0; st < 2; ++st)
#pragma unroll
                    for (int tt = 0; tt < 2; ++tt) XT[st][tt] = MFMA16(kf[st], qf[tt], XT[st][tt]);
            }
#pragma unroll
            for (int st = 0; st < 2; ++st)
#pragma unroll
                for (int tt = 0; tt < 2; ++tt)
#pragma unroll
                    for (int rg = 0; rg < 4; ++rg) {
                        const int s = 16 * st + 4 * q4 + rg, t = 16 * tt + j;
                        const bool keep = DIR == 0 ? (s <= t) : (s >= t);
                        XT[st][tt][rg] = keep ? XT[st][tt][rg] : 0.f;
                    }
            const bf16x8 vf = ld2x8(shm + H3_VT + (v0 + j) * HROW + (32 * I + 4 * q4) * 2, 32);
#pragma unroll
            for (int tt = 0; tt < 2; ++tt) {
                const bf16x8 pa = pack8(XT[0][tt][0], XT[0][tt][1], XT[0][tt][2], XT[0][tt][3], XT[1][tt][0], XT[1][tt][1], XT[1][tt][2], XT[1][tt][3]);
                O[I][tt] = MFMA16(pa, vf, O[I][tt]);
            }
        }
        {
            const float* gd = (const float*)(shm + H3_GDEC) + I * 128 + 4 * q4;
            const bf16x8 vb = *(const bf16x8*)(shm + H3_VT + (v0 + j) * HROW + (32 * I + 8 * q4) * 2);
#pragma unroll
            for (int dt = 0; dt < 8; ++dt) {
                const f32x4 g4 = *(const f32x4*)(gd + 16 * dt);
                S[dt] = S[dt] * g4;
                const bf16x8 ka = *(const bf16x8*)(shm + H3_KHT + (16 * dt + j) * HROW + (32 * I + 8 * q4) * 2);
                S[dt] = MFMA16(ka, vb, S[dt]);
            }
        }
    }
}

DI void phase_hgrn_pass3(const bf16_t* __restrict__ proj, const float* __restrict__ lb, const bf16_t* __restrict__ states, bf16_t* __restrict__ y, const float* __restrict__ hog) {
    extern __shared__ __attribute__((aligned(16))) char shm[];
#pragma unroll 1
    for (int item = obid(); item < NB * 4 * 64; item += ogdim()) {
        const int tid = otid(), wave = __builtin_amdgcn_readfirstlane(tid >> 6), lane = tid & 63, j = lane & 15, q4 = lane >> 4;
        const int b = item >> 8, h = (item >> 6) & 3, m = item & 63;
        const size_t tok0 = (size_t)b * S_ + m * 128;
        const int v0 = wave * 16;
        __syncthreads();
        {
            const int s = tid & 127, vg = tid >> 7;
            const bf16_t* ip = proj + pidx(6, b, h, m * 128 + s) + vg * 32;
            bf16_t* vtl = (bf16_t*)(shm + H3_VT);
#pragma unroll
            for (int jj = 0; jj < 4; ++jj) {
                const u32x4 w = *(const u32x4*)(ip + jj * 8);
                const unsigned ww[4] = {w.x, w.y, w.z, w.w};
#pragma unroll
                for (int e = 0; e < 4; ++e) {
                    const int v = vg * 32 + jj * 8 + e * 2;
                    vtl[v * 136 + s] = (bf16_t)(ww[e] & 0xffffu);
                    vtl[(v + 1) * 136 + s] = (bf16_t)(ww[e] >> 16);
                }
            }
        }
        float qv[32];
        {
            const int d = tid & 127, seg = tid >> 7;
            const bf16_t* qp = proj + pidx(3, b, h, m * 128 + seg * 32) + d;
#pragma unroll
            for (int i = 0; i < 32; ++i) qv[i] = bf2f(qp[i * 128]);
        }
        f32x4 O[4][2];
#pragma unroll
        for (int I = 0; I < 4; ++I)
#pragma unroll
            for (int tt = 0; tt < 2; ++tt) O[I][tt] = (f32x4){0.f, 0.f, 0.f, 0.f};
#pragma unroll 1
        for (int dir = 0; dir < 2; ++dir) {
            hgrn3_stage(proj, lb, dir, b, h, m, shm, qv);
            const int sidx = ((dir * 4 + b) * 4 + h) * 64 + m;
            const bf16_t* sp = states + (size_t)sidx * 16384 + (v0 + j) * 128 + 4 * q4;
            f32x4 S[8];
#pragma unroll
            for (int dt = 0; dt < 8; ++dt) { const u32x2 w = *(const u32x2*)(sp + 16 * dt); S[dt] = (f32x4){bflo(w.x), bfhi(w.x), bflo(w.y), bfhi(w.y)}; }
            __syncthreads();
            if (dir == 0) hgrn3_mma<0>(shm, S, O, v0, j, q4); else hgrn3_mma<1>(shm, S, O, v0, j, q4);
            __syncthreads();
        }
        float* ssq = (float*)(shm + H3_SSQ);
#pragma unroll
        for (int I = 0; I < 4; ++I)
#pragma unroll
            for (int tt = 0; tt < 2; ++tt)
#pragma unroll
                for (int rg = 0; rg < 4; ++rg) {
                    float ss = O[I][tt][rg] * O[I][tt][rg];
                    ss += dpp_ror<8>(ss); ss += dpp_ror<4>(ss); ss += dpp_ror<2>(ss); ss += dpp_ror<1>(ss);
                    if (j == 0) ssq[wave * 128 + 32 * I + 16 * tt + 4 * q4 + rg] = ss;
                }
        __syncthreads();
        if (tid < 128) { float s = 0.f;
#pragma unroll
            for (int w = 0; w < 8; ++w) s += ssq[w * 128 + tid];
            ((float*)(shm + H3_GDEC))[tid] = 1.0f / sqrtf(s * (1.f / 128.f) + EPS); }
        __syncthreads();
        const float* rstdv = (const float*)(shm + H3_GDEC);
        const float og = hog[v0 + j];
        bf16_t gl[4][2][4];
#pragma unroll
        for (int I = 0; I < 4; ++I)
#pragma unroll
            for (int tt = 0; tt < 2; ++tt)
#pragma unroll
                for (int rg = 0; rg < 4; ++rg) gl[I][tt][rg] = proj[pidx(7, b, h, m * 128 + 32 * I + 16 * tt + 4 * q4 + rg) + v0 + j];
#pragma unroll
        for (int I = 0; I < 4; ++I)
#pragma unroll
            for (int tt = 0; tt < 2; ++tt)
#pragma unroll
                for (int rg = 0; rg < 4; ++rg) {
                    const int tl = 32 * I + 16 * tt + 4 * q4 + rg;
                    const size_t tok = tok0 + tl;
                    const float g = bf2f(gl[I][tt][rg]);
                    const float sg = g * __builtin_amdgcn_rcpf(1.f + fexp(-g));
                    y[tok * D_ + 512 + h * 128 + v0 + j] = f2bf(O[I][tt][rg] * rstdv[tl] * og * sg);
                }
    }
}

DI void phase_glu(const bf16_t* __restrict__ u, bf16_t* __restrict__ act, const float* __restrict__ cw, const float* __restrict__ cb) {
    const int gt = obid() * NTHREADS + otid();
    constexpr int NCG = DFF / 8, NSTRIP = 16384 / 32;
    for (int unit = gt; unit < NSTRIP * NCG; unit += ogdim() * NTHREADS) {
        const int strip = unit / NCG, cgp = unit % NCG, j0 = cgp * 8, r0 = strip * 32;
        float w[2][3][8], bb[2][8];
#pragma unroll
        for (int hf = 0; hf < 2; ++hf) {
#pragma unroll
            for (int k = 0; k < 3; ++k) {
                const f32x4 a = *(const f32x4*)(cw + (size_t)k * DUP + hf * DFF + j0), c = *(const f32x4*)(cw + (size_t)k * DUP + hf * DFF + j0 + 4);
                w[hf][k][0] = a.x; w[hf][k][1] = a.y; w[hf][k][2] = a.z; w[hf][k][3] = a.w; w[hf][k][4] = c.x; w[hf][k][5] = c.y; w[hf][k][6] = c.z; w[hf][k][7] = c.w;
            }
            const f32x4 a = *(const f32x4*)(cb + hf * DFF + j0), c = *(const f32x4*)(cb + hf * DFF + j0 + 4);
            bb[hf][0] = a.x; bb[hf][1] = a.y; bb[hf][2] = a.z; bb[hf][3] = a.w; bb[hf][4] = c.x; bb[hf][5] = c.y; bb[hf][6] = c.z; bb[hf][7] = c.w;
        }
        u32x4 pa, pv, ca, cv, na, nv;
        const u32x4 zero = {0u, 0u, 0u, 0u};
        const bool first = (r0 & 8191) == 0;
        pa = first ? zero : *(const u32x4*)(u + (size_t)(r0 - 1) * DUP + j0);
        pv = first ? zero : *(const u32x4*)(u + (size_t)(r0 - 1) * DUP + DFF + j0);
        ca = *(const u32x4*)(u + (size_t)r0 * DUP + j0);
        cv = *(const u32x4*)(u + (size_t)r0 * DUP + DFF + j0);
#pragma unroll 4
        for (int i = 0; i < 32; ++i) {
            const int rr = r0 + i;
            const bool last = (rr & 8191) == 8191;
            na = last ? zero : *(const u32x4*)(u + (size_t)(rr + 1) * DUP + j0);
            nv = last ? zero : *(const u32x4*)(u + (size_t)(rr + 1) * DUP + DFF + j0);
            const unsigned pA[4] = {pa.x, pa.y, pa.z, pa.w}, cA[4] = {ca.x, ca.y, ca.z, ca.w}, nA[4] = {na.x, na.y, na.z, na.w};
            const unsigned pV[4] = {pv.x, pv.y, pv.z, pv.w}, cV[4] = {cv.x, cv.y, cv.z, cv.w}, nV[4] = {nv.x, nv.y, nv.z, nv.w};
            float res[8];
#pragma unroll
            for (int e = 0; e < 4; ++e) {
                const float a0 = w[0][0][2 * e] * bflo(pA[e]) + w[0][1][2 * e] * bflo(cA[e]) + w[0][2][2 * e] * bflo(nA[e]) + bb[0][2 * e];
                const float a1 = w[0][0][2 * e + 1] * bfhi(pA[e]) + w[0][1][2 * e + 1] * bfhi(cA[e]) + w[0][2][2 * e + 1] * bfhi(nA[e]) + bb[0][2 * e + 1];
                const float v0 = w[1][0][2 * e] * bflo(pV[e]) + w[1][1][2 * e] * bflo(cV[e]) + w[1][2][2 * e] * bflo(nV[e]) + bb[1][2 * e];
                const float v1 = w[1][0][2 * e + 1] * bfhi(pV[e]) + w[1][1][2 * e + 1] * bfhi(cV[e]) + w[1][2][2 * e + 1] * bfhi(nV[e]) + bb[1][2 * e + 1];
                res[2 * e] = a0 / (1.f + expf(-a0)) * v0; res[2 * e + 1] = a1 / (1.f + expf(-a1)) * v1;
            }
            u32x4 o; o.x = pk2(res[0], res[1]); o.y = pk2(res[2], res[3]); o.z = pk2(res[4], res[5]); o.w = pk2(res[6], res[7]);
            *(u32x4*)(act + (size_t)rr * DFF + j0) = o;
            pa = ca; pv = cv; ca = na; cv = nv;
        }
    }
}

#define XB_TMO      128
#define XB_XCNT(j)  (256  + 64 * (j))
#define XB_XSUB(j)  (1280 + 64 * (j))
#define XB_XGEN(j)  (2304 + 64 * (j))
#define XB_TOP      3328
#define XB_TOPGEN   3392
#define XCD_BAR_WORDS 3456
#define XB_SPIN_CAP (1u << 22)
DI unsigned xb_ld(unsigned* p) { return __hip_atomic_load(p, __ATOMIC_RELAXED, __HIP_MEMORY_SCOPE_AGENT); }
DI unsigned xb_add(unsigned* p, unsigned v) { return __hip_atomic_fetch_add(p, v, __ATOMIC_RELAXED, __HIP_MEMORY_SCOPE_AGENT); }
DI unsigned xb_xcc_id() { return (unsigned)__builtin_amdgcn_s_getreg((3 << 11) | 20) & 0xFu; }
#define XB_SPIN(cond, bar) do { unsigned _sp = 0; while (cond) { __builtin_amdgcn_s_sleep(1); \
    if ((++_sp & 255u) == 0u) { if (xb_ld(&(bar)[XB_TMO])) break; if (_sp > XB_SPIN_CAP) { atomicAdd(&(bar)[XB_TMO], 1u); break; } } } } while (0)
struct XcdBarrier { unsigned* bar; unsigned x; volatile unsigned* st; };
DI XcdBarrier xcd_barrier_post(unsigned* bar, volatile unsigned* st) {
    XcdBarrier b; b.bar = bar; b.x = xb_xcc_id(); b.st = st;
    if (threadIdx.x == 0) (void)xb_add(&bar[XB_XCNT(b.x)], 1u);
    return b;
}
DI void xcd_barrier_complete(unsigned* bar, unsigned x, unsigned& nloc, unsigned& nx) {
    const unsigned G = gridDim.x;
    unsigned sum, cnt, mine, sp = 0u;
    for (;;) {
        sum = 0u; cnt = 0u; mine = 0u;
#pragma unroll 1
        for (unsigned j = 0; j < 16; ++j) { const unsigned c = xb_ld(&bar[XB_XCNT(j)]); sum += c; cnt += (c > 0u) ? 1u : 0u; mine = (j == x) ? c : mine; }
        if (sum == G) break;
        __builtin_amdgcn_s_sleep(1);
        if ((++sp & 255u) == 0u) { if (xb_ld(&bar[XB_TMO])) break; if (sp > XB_SPIN_CAP) { atomicAdd(&bar[XB_TMO], 1u); break; } }
    }
    nloc = mine > 0u ? mine : 1u; nx = cnt > 0u ? cnt : 1u;
}
DI void xcd_barrier(const XcdBarrier& b) {
    asm volatile("s_waitcnt vmcnt(0)" ::: "memory");
    __syncthreads();
    if (threadIdx.x == 0) {
        unsigned* bar = b.bar;
        __builtin_amdgcn_s_waitcnt(0);
        const unsigned nloc = b.st[0], nx = b.st[1];
        const unsigned old = xb_add(&bar[XB_XSUB(b.x)], 1u);
        const unsigned gen = old / nloc;
        if (old + 1u == (gen + 1u) * nloc) {
            __builtin_amdgcn_fence(__ATOMIC_RELEASE, "agent");
            asm volatile("s_waitcnt vmcnt(0)" ::: "memory");
            const unsigned og = xb_add(&bar[XB_TOP], 1u);
            const unsigned tg = og / nx;
            if (og + 1u == (tg + 1u) * nx) xb_add(&bar[XB_TOPGEN], 1u);
            else XB_SPIN(xb_ld(&bar[XB_TOPGEN]) == tg, bar);
            __builtin_amdgcn_fence(__ATOMIC_ACQUIRE, "agent");
            xb_add(&bar[XB_XGEN(b.x)], 1u);
            asm volatile("s_waitcnt vmcnt(0)" ::: "memory");
        } else {
            XB_SPIN(xb_ld(&bar[XB_XGEN(b.x)]) == gen, bar);
            __builtin_amdgcn_fence(__ATOMIC_ACQUIRE, "agent");
            asm volatile("s_waitcnt vmcnt(0)" ::: "memory");
        }
    }
    __syncthreads();
}

enum { PH_PROLOGUE = 0, PH_NORM1, PH_INPROJ, PH_PREP, PH_SCAN, PH_MIX, PH_OUTPROJ, PH_NORM2, PH_UP, PH_GLU, PH_DOWN };

template <int PH>
DI void run_phase(const Params& p, int l, int hf) {
    extern __shared__ __attribute__((aligned(16))) char shm[];
    unsigned char* ws = p.ws;
    bf16_t* hbuf = (bf16_t*)(ws + OFF_H);
    bf16_t* states = (bf16_t*)(ws + OFF_H);
    float* dec = (float*)(ws + OFF_DEC);
    bf16_t* vt = (bf16_t*)(ws + OFF_VT);
    bf16_t* proj = (bf16_t*)(ws + OFF_PROJ);
    bf16_t* ybuf = (bf16_t*)(ws + OFF_Y);
    bf16_t* halo = (bf16_t*)(ws + OFF_HALO);
    bf16_t* actbuf = (bf16_t*)(ws + OFF_ACT);
    const float* rope = (const float*)(ws + OFF_ROPE);
    const float* misc = (const float*)(ws + OFF_MISC);
    const float* xin = l == 0 ? p.x : p.out;
    if (PH == PH_PROLOGUE) { phase_prologue(p, shm); phase_rmsnorm(p.x, p.mix_g, hbuf); }
    if (PH == PH_NORM1) phase_rmsnorm(xin, p.mix_g + l * D_, hbuf);
    if (PH == PH_INPROJ) { EpiArgs ea; ea.ob = proj; ea.ldo = DIN; ea.vt = vt; ea.resid = nullptr; ea.of = nullptr; ea.lb = misc + l * 1024; ea.cw = nullptr; ea.cb = nullptr; ea.halo = nullptr; ea.ssqp = nullptr; ea.cnt = nullptr; ea.gn = nullptr; ea.hn = nullptr;
        gemm_phase<EPI_PROJ>(hbuf, (const bf16_t*)(ws + OFF_WIN) + (size_t)l * 4096 * 1024, T_, DIN, D_, ea); }
    if (PH == PH_PREP) { phase_qkprep(proj, rope, p.kg + l * 64); phase_hgrn_pass1(proj, misc + l * 1024, states, dec); }
    if (PH == PH_SCAN) phase_hgrn_scan(states, dec);
    if (PH == PH_MIX) {
        const float lamv = __int_as_float(__builtin_amdgcn_readfirstlane(__float_as_int(misc[2048 + l])));
        const float oscv = __int_as_float(__builtin_amdgcn_readfirstlane(__float_as_int(misc[2052 + l])));
        const float mbv = __int_as_float(__builtin_amdgcn_readfirstlane(__float_as_int(misc[2050 + l])));
        if (mbv > 60.f) phase_attention<true>(proj, vt, ybuf, p.dog + l * 128, lamv, oscv, mbv, rope, p.qg + l * 64);
        else phase_attention<false>(proj, vt, ybuf, p.dog + l * 128, lamv, oscv, 0.f, rope, p.qg + l * 64);
        phase_hgrn_pass3(proj, misc + l * 1024, states, ybuf, p.hog + l * 128);
    }
    if (PH == PH_OUTPROJ) { EpiArgs ea; ea.ob = nullptr; ea.ldo = 0; ea.vt = nullptr; ea.resid = xin; ea.of = p.out; ea.lb = nullptr; ea.cw = nullptr; ea.cb = nullptr; ea.halo = nullptr;
        ea.hn = hbuf; ea.gn = p.ffn_g + l * D_; ea.ssqp = (float*)(ws + OFF_SSQ) + (size_t)(2 * l) * T_ * 16; ea.cnt = (unsigned*)(ws + OFF_BAR) + CNT_WORD + (2 * l) * 128;
        gemm_phase<EPI_RESIDN>(ybuf, (const bf16_t*)(ws + OFF_WOUT) + (size_t)l * 1024 * 1024, T_, D_, D_, ea); }
    if (PH == PH_NORM2) phase_rmsnorm(p.out, p.ffn_g + l * D_, hbuf);
    if (PH == PH_UP) { EpiArgs ea; ea.ob = actbuf; ea.ldo = DFF; ea.vt = nullptr; ea.resid = nullptr; ea.of = nullptr; ea.lb = nullptr;
        ea.cw = p.conv_w + (size_t)l * 3 * DUP; ea.cb = p.conv_b + (size_t)l * DUP; ea.halo = halo; ea.ssqp = nullptr; ea.cnt = nullptr; ea.gn = nullptr; ea.hn = nullptr;
        gemm_phase<EPI_GLU>(hbuf, (const bf16_t*)(ws + OFF_WUP) + (size_t)l * 5632 * 1024, T_, DUP, D_, ea); }
    if (PH == PH_GLU) phase_glu_fixup(halo, actbuf, p.conv_w + (size_t)l * 3 * DUP, p.conv_b + (size_t)l * DUP);
    if (PH == PH_DOWN) { EpiArgs ea; ea.ob = nullptr; ea.ldo = 0; ea.vt = nullptr; ea.resid = p.out; ea.of = p.out; ea.lb = nullptr; ea.cw = nullptr; ea.cb = nullptr; ea.halo = nullptr;
        ea.hn = nullptr; ea.gn = nullptr; ea.ssqp = nullptr; ea.cnt = nullptr;
        if (l == 0) { ea.hn = hbuf; ea.gn = p.mix_g + D_; ea.ssqp = (float*)(ws + OFF_SSQ) + (size_t)1 * T_ * 16; ea.cnt = (unsigned*)(ws + OFF_BAR) + CNT_WORD + 128;
            gemm_phase<EPI_RESIDN>(actbuf, (const bf16_t*)(ws + OFF_WDN), T_, D_, DFF, ea); }
        else gemm_phase<EPI_RESID>(actbuf, (const bf16_t*)(ws + OFF_WDN) + (size_t)l * 1024 * 2816, T_, D_, DFF, ea); }
}

#ifndef FUSED
#define FUSED 1
#endif

#if FUSED
__global__ void __launch_bounds__(NTHREADS) fwd_megakernel(Params p) {
    extern __shared__ __attribute__((aligned(16))) char shm[];
    cg::grid_group grid = cg::this_grid();
    volatile unsigned* st = (volatile unsigned*)(shm + LDS_MAIN);
    if (threadIdx.x == 0) { st[0] = 0u; st[1] = 0u; }
    __syncthreads();
    const XcdBarrier xb = xcd_barrier_post((unsigned*)(p.ws + OFF_BAR), st);
    run_phase<PH_PROLOGUE>(p, 0, 0); grid.sync();
    if (threadIdx.x == 0) { unsigned nloc, nx; xcd_barrier_complete(xb.bar, xb.x, nloc, nx); st[0] = nloc; st[1] = nx; }
    __syncthreads();
#pragma unroll 1
    for (int l = 0; l < 2; ++l) {
        run_phase<PH_INPROJ>(p, l, 0); xcd_barrier(xb);
        run_phase<PH_PREP>(p, l, 0); xcd_barrier(xb);
        run_phase<PH_SCAN>(p, l, 0); xcd_barrier(xb);
        run_phase<PH_MIX>(p, l, 0); xcd_barrier(xb);
        run_phase<PH_OUTPROJ>(p, l, 0); xcd_barrier(xb);
        run_phase<PH_UP>(p, l, 0); xcd_barrier(xb);
        run_phase<PH_GLU>(p, l, 0); xcd_barrier(xb);
        run_phase<PH_DOWN>(p, l, 0); xcd_barrier(xb);
    }
}
#else
template <int PH>
__global__ void __launch_bounds__(NTHREADS) k_phase(Params p, int l, int hf) { run_phase<PH>(p, l, hf); }
#endif

template <int PH>
static void launch_phase(const Params& p, int l, int hf, int grid, hipStream_t stream) {
#if !FUSED
    static bool attr_set = false;
    if (!attr_set) { (void)hipFuncSetAttribute((const void*)k_phase<PH>, hipFuncAttributeMaxDynamicSharedMemorySize, LDS_BYTES); attr_set = true; }
    hipLaunchKernelGGL(k_phase<PH>, dim3(grid), dim3(NTHREADS), LDS_BYTES, stream, p, l, hf);
#endif
}

extern "C" void kernel_launch(void* const* d_in, const int* in_sizes, int n_in, void* d_out, int out_size, void* d_ws, size_t ws_size, hipStream_t stream) {
    static int grid_blocks = 0;
    if (grid_blocks == 0) {
        if (n_in != 19 || ws_size < WS_END) { fprintf(stderr, "kernel_launch: unexpected n_in %d or ws_size %zu (< %zu)\n", n_in, ws_size, (size_t)WS_END); grid_blocks = -1; return; }
        int dev = 0, cus = 0, per_cu = 1;
        (void)hipGetDevice(&dev);
        (void)hipDeviceGetAttribute(&cus, hipDeviceAttributeMultiprocessorCount, dev);
#if FUSED
        (void)hipFuncSetAttribute((const void*)fwd_megakernel, hipFuncAttributeMaxDynamicSharedMemorySize, LDS_BYTES);
        (void)hipOccupancyMaxActiveBlocksPerMultiprocessor(&per_cu, (const void*)fwd_megakernel, NTHREADS, LDS_BYTES);
        if (per_cu < 1) per_cu = 1;
#endif
        grid_blocks = cus * per_cu;
        (void)hipGetLastError();
    }
    if (grid_blocks < 0) return;
    Params p{};
    p.x = (const float*)d_in[0]; p.pos = (const int*)d_in[1]; p.mix_g = (const float*)d_in[2]; p.w_in = (const float*)d_in[3];
    p.qg = (const float*)d_in[4]; p.kg = (const float*)d_in[5]; p.lq1 = (const float*)d_in[6]; p.lk1 = (const float*)d_in[7];
    p.lq2 = (const float*)d_in[8]; p.lk2 = (const float*)d_in[9]; p.dog = (const float*)d_in[10]; p.lbl = (const float*)d_in[11];
    p.hog = (const float*)d_in[12]; p.w_out = (const float*)d_in[13]; p.ffn_g = (const float*)d_in[14]; p.w_up = (const float*)d_in[15];
    p.conv_w = (const float*)d_in[16]; p.conv_b = (const float*)d_in[17]; p.w_down = (const float*)d_in[18];
    p.out = (float*)d_out; p.ws = (unsigned char*)d_ws;
#if FUSED
    (void)hipMemsetAsync((char*)d_ws + OFF_BAR, 0, 16384, stream);
    void* args[] = {&p};
    hipError_t e = hipLaunchCooperativeKernel((const void*)fwd_megakernel, dim3(grid_blocks), dim3(NTHREADS), args, LDS_BYTES, stream);
    if (e != hipSuccess) fprintf(stderr, "cooperative launch failed: %s (grid %d)\n", hipGetErrorString(e), grid_blocks);
#else
    const int g = grid_blocks;
    launch_phase<PH_PROLOGUE>(p, 0, 0, g, stream);
    for (int l = 0; l < 2; ++l) {
        launch_phase<PH_NORM1>(p, l, 0, g, stream);
        launch_phase<PH_INPROJ>(p, l, 0, g, stream);
        launch_phase<PH_PREP>(p, l, 0, g, stream);
        launch_phase<PH_SCAN>(p, l, 0, g, stream);
        launch_phase<PH_MIX>(p, l, 0, g, stream);
        launch_phase<PH_OUTPROJ>(p, l, 0, g, stream);
        launch_phase<PH_NORM2>(p, l, 0, g, stream);
        for (int hf = 0; hf < 2; ++hf) {
            launch_phase<PH_UP>(p, l, hf, g, stream);
            launch_phase<PH_GLU>(p, l, hf, g, stream);
            launch_phase<PH_DOWN>(p, l, hf, g, stream);
        }
    }
#endif
}
```

```cpp
#include <hip/hip_runtime.h>
#include <hip/hip_cooperative_groups.h>
#include <cstdio>
#include <cstdint>
namespace cg = cooperative_groups;

typedef unsigned short bf16_t;
typedef short bf16x8 __attribute__((ext_vector_type(8)));
typedef short s16x4 __attribute__((ext_vector_type(4)));
typedef float f32x2 __attribute__((ext_vector_type(2)));
typedef float f32x4 __attribute__((ext_vector_type(4)));
typedef float f32x16 __attribute__((ext_vector_type(16)));
typedef unsigned u32x2 __attribute__((ext_vector_type(2)));
typedef unsigned u32x4 __attribute__((ext_vector_type(4)));
typedef __bf16 bfv2 __attribute__((ext_vector_type(2)));

#define DI __device__ __forceinline__

constexpr int T_ = 32768, S_ = 8192, NB = 4, D_ = 1024, DIN = 4096, DFF = 2816, DUP = 5632;
constexpr int NTHREADS = 512, NWAVES = 8;
constexpr int LDS_MAIN = 144 * 1024;
constexpr int LDS_BYTES = LDS_MAIN + 16;
constexpr float EPS = 1e-6f;
constexpr float LOG2E = 1.4426950408889634f, LN2 = 0.6931471805599453f;

constexpr size_t OFF_WIN = 0;
constexpr size_t OFF_WOUT = OFF_WIN + 2ull * 4096 * 1024 * 2;
constexpr size_t OFF_WUP = OFF_WOUT + 2ull * 1024 * 1024 * 2;
constexpr size_t OFF_WDN = OFF_WUP + 2ull * 5632 * 1024 * 2;
constexpr size_t OFF_ROPE = OFF_WDN + 2ull * 1024 * 2816 * 2;
constexpr size_t OFF_MISC = OFF_ROPE + (size_t)T_ * 64 * 4;
constexpr size_t OFF_H = OFF_MISC + 65536;
constexpr size_t OFF_DEC = OFF_H + (size_t)T_ * 1024 * 2;
constexpr size_t OFF_VT = OFF_DEC + 2048ull * 128 * 4;
constexpr size_t OFF_PROJ = OFF_VT + (size_t)T_ * 512 * 2;
constexpr size_t OFF_Y = OFF_PROJ + (size_t)T_ * 4096 * 2;
constexpr size_t OFF_BAR = OFF_Y + (size_t)T_ * 1024 * 2;
constexpr size_t OFF_SSQ = OFF_BAR + 16384;
constexpr size_t WS_END = OFF_SSQ + 3ull * T_ * 16 * 4;
constexpr int CNT_WORD = 3584;
constexpr size_t OFF_ACT = OFF_PROJ;
constexpr size_t OFF_HALO = OFF_Y;

struct Params {
    const float* x; const int* pos; const float* mix_g; const float* w_in; const float* qg; const float* kg;
    const float* lq1; const float* lk1; const float* lq2; const float* lk2; const float* dog; const float* lbl; const float* hog;
    const float* w_out; const float* ffn_g; const float* w_up; const float* conv_w; const float* conv_b; const float* w_down;
    float* out; unsigned char* ws;
};

DI unsigned pk2(float lo, float hi) { f32x2 v = {lo, hi}; bfv2 r = __builtin_convertvector(v, bfv2); return __builtin_bit_cast(unsigned, r); }
DI float bf2f(bf16_t h) { return __uint_as_float((unsigned)h << 16); }
DI float bflo(unsigned u) { return __uint_as_float(u << 16); }
DI float bfhi(unsigned u) { return __uint_as_float(u & 0xffff0000u); }
DI bf16_t f2bf(float f) { return (bf16_t)(pk2(f, 0.f) & 0xffffu); }
DI bf16x8 pack8(float a0, float a1, float a2, float a3, float a4, float a5, float a6, float a7) {
    u32x4 p; p.x = pk2(a0, a1); p.y = pk2(a2, a3); p.z = pk2(a4, a5); p.w = pk2(a6, a7); return __builtin_bit_cast(bf16x8, p);
}
DI int otid() { int t = threadIdx.x; asm volatile("" : "+v"(t)); return t; }
DI float shx(float v, int m) { const int l = otid() & 63; return __builtin_bit_cast(float, __builtin_amdgcn_ds_bpermute((l ^ m) << 2, __builtin_bit_cast(int, v))); }
DI float shl_(float v, int srclane) { return __builtin_bit_cast(float, __builtin_amdgcn_ds_bpermute(srclane << 2, __builtin_bit_cast(int, v))); }
DI float wave_sum(float v) {
#pragma unroll
    for (int o = 1; o < 64; o <<= 1) v += shx(v, o);
    return v;
}
DI float wave_max(float v) {
#pragma unroll
    for (int o = 1; o < 64; o <<= 1) v = fmaxf(v, shx(v, o));
    return v;
}
DI size_t pidx(int g, int b, int h, int s) { return ((size_t)((g * 4 + b) * 4 + h) * S_ + s) * 128; }
DI int obid() { int b = blockIdx.x; asm volatile("" : "+s"(b)); return b; }
DI int ogdim() { int g = gridDim.x; asm volatile("" : "+s"(g)); return g; }
DI float fexp(float x) { return __builtin_amdgcn_exp2f(x * LOG2E); }
DI int crow(int reg, int h) { return (reg & 3) + 8 * (reg >> 2) + 4 * h; }
#define MFMA32(a, b, c) __builtin_amdgcn_mfma_f32_32x32x16_bf16((a), (b), (c), 0, 0, 0)

DI void transpose_load(const float* W, int N, int nblk, int item, float* scr, int lane) {
    const int kb = item / nblk, nb = item % nblk, k0 = 64 * kb, n0 = 64 * nb;
    const int n4 = lane & 15, kq = lane >> 4;
    f32x4 v[16];
#pragma unroll
    for (int i = 0; i < 16; ++i) v[i] = *(const f32x4*)(W + (size_t)(k0 + 4 * i + kq) * N + n0 + 4 * n4);
#pragma unroll
    for (int i = 0; i < 16; ++i) { float* s = scr + (4 * i + kq) * 65 + 4 * n4; s[0] = v[i].x; s[1] = v[i].y; s[2] = v[i].z; s[3] = v[i].w; }
}
DI void transpose_store(bf16_t* WT, int K, int nblk, int item, const float* scr, int lane, bool glu_perm) {
    const int kb = item / nblk, nb = item % nblk, k0 = 64 * kb;
    int n0 = 64 * nb;
    if (glu_perm) n0 = n0 < DFF ? ((n0 >> 7) << 8) + (n0 & 127) : (((n0 - DFF) >> 7) << 8) + 128 + ((n0 - DFF) & 127);
    const int c = lane & 7;
#pragma unroll
    for (int j = 0; j < 8; ++j) {
        const int n = (lane >> 3) + 8 * j; const float* s = scr + (8 * c) * 65 + n;
        u32x4 o; o.x = pk2(s[0], s[65]); o.y = pk2(s[130], s[195]); o.z = pk2(s[260], s[325]); o.w = pk2(s[390], s[455]);
        *(u32x4*)(WT + (size_t)(n0 + n) * K + k0 + 8 * c) = o;
    }
}

DI void phase_prologue(const Params& p, char* shm) {
    const int tid = otid(), wave = tid >> 6, lane = tid & 63;
    float* scr = (float*)shm + wave * (64 * 65);
    constexpr int I_IN = 16 * 64, I_OUT = 16 * 16, I_UP = 16 * 88, I_DN = 44 * 16, I_L = I_IN + I_OUT + I_UP + I_DN, NITEMS = 2 * I_L;
    for (int base = obid() * NWAVES; base < NITEMS; base += ogdim() * NWAVES) {
        const int it = base + wave; const bool act = it < NITEMS;
        const float* W = nullptr; bf16_t* WT = nullptr; int K = 0, N = 0, r = 0;
        if (act) {
            const int l = it / I_L; r = it % I_L;
            if (r < I_IN) { W = p.w_in + (size_t)l * 1024 * 4096; WT = (bf16_t*)(p.ws + OFF_WIN) + (size_t)l * 4096 * 1024; K = 1024; N = 4096; }
            else if ((r -= I_IN) < I_OUT) { W = p.w_out + (size_t)l * 1024 * 1024; WT = (bf16_t*)(p.ws + OFF_WOUT) + (size_t)l * 1024 * 1024; K = 1024; N = 1024; }
            else if ((r -= I_OUT) < I_UP) { W = p.w_up + (size_t)l * 1024 * 5632; WT = (bf16_t*)(p.ws + OFF_WUP) + (size_t)l * 5632 * 1024; K = 1024; N = 5632; }
            else { r -= I_UP; W = p.w_down + (size_t)l * 2816 * 1024; WT = (bf16_t*)(p.ws + OFF_WDN) + (size_t)l * 1024 * 2816; K = 2816; N = 1024; }
            transpose_load(W, N, N / 64, r, scr, lane);
        }
        __syncthreads();
        if (act) transpose_store(WT, K, N / 64, r, scr, lane, N == DUP);
        __syncthreads();
    }
    float* rope = (float*)(p.ws + OFF_ROPE);
    for (int e = obid() * NTHREADS + tid; e < T_ * 32; e += ogdim() * NTHREADS) {
        const int t = e >> 5, i = e & 31;
        const float inv_freq = exp2f(-(float)i * (13.287712379549449f / 32.f));
        const float ang = (float)p.pos[t] * inv_freq;
        double rev = (double)ang * 0.15915494309189535; rev -= rint(rev);
        const float fr = (float)rev;
        rope[(size_t)t * 64 + i] = __builtin_amdgcn_cosf(fr);
        rope[(size_t)t * 64 + 32 + i] = __builtin_amdgcn_sinf(fr);
    }
    if (obid() == 0) {
        float* misc = (float*)(p.ws + OFF_MISC);
        for (int e = tid; e < 1024; e += NTHREADS) {
            const float a0 = p.lbl[e], a1 = p.lbl[1024 + e];
            const float m = fmaxf(a0, a1), e0 = expf(a0 - m), e1 = expf(a1 - m), p0 = e0 / (e0 + e1), p1 = e1 / (e0 + e1);
            const float l0 = p0 - p0, l1 = (p0 + p1) - p0;
            misc[e] = fminf(fmaxf(l0, 0.f), 1.f - 1e-4f);
            misc[1024 + e] = fminf(fmaxf(l1, 0.f), 1.f - 1e-4f);
        }
        if (wave < 2) {
            const int l = wave;
            const float s1 = wave_sum(p.lq1[l * 64 + lane] * p.lk1[l * 64 + lane]);
            const float s2 = wave_sum(p.lq2[l * 64 + lane] * p.lk2[l * 64 + lane]);
            const float mq = wave_max(fabsf(p.qg[l * 64 + lane])), mk = wave_max(fabsf(p.kg[l * 64 + lane]));
            const float lam_init = 0.8f - 0.6f * expf(-0.3f * (float)l);
            if (lane == 0) { misc[2048 + l] = expf(s1) - expf(s2) + lam_init; misc[2050 + l] = 8.f * mq * mk * LOG2E + 0.5f; misc[2052 + l] = 1.f - lam_init; }
        }
    }
}

DI void phase_rmsnorm(const float* __restrict__ x, const float* __restrict__ g, bf16_t* __restrict__ h) {
    const int tid = otid(), wave = tid >> 6, lane = tid & 63;
    f32x4 gv[4];
#pragma unroll
    for (int j = 0; j < 4; ++j) gv[j] = ((const f32x4*)g)[lane + 64 * j];
    for (int row0 = (obid() * NWAVES + wave) * 4; row0 < T_; row0 += ogdim() * NWAVES * 4) {
        f32x4 v[4][4]; float s[4];
#pragma unroll
        for (int rr = 0; rr < 4; ++rr) {
            const f32x4* xr = (const f32x4*)(x + (size_t)(row0 + rr) * D_) + lane;
            s[rr] = 0.f;
#pragma unroll
            for (int j = 0; j < 4; ++j) { v[rr][j] = xr[64 * j]; s[rr] += (v[rr][j].x * v[rr][j].x + v[rr][j].y * v[rr][j].y) + (v[rr][j].z * v[rr][j].z + v[rr][j].w * v[rr][j].w); }
        }
#pragma unroll
        for (int o = 1; o < 64; o <<= 1) {
#pragma unroll
            for (int rr = 0; rr < 4; ++rr) s[rr] += shx(s[rr], o);
        }
#pragma unroll
        for (int rr = 0; rr < 4; ++rr) {
            const float rstd = 1.0f / sqrtf(s[rr] * (1.f / D_) + EPS);
            u32x2* o = (u32x2*)(h + (size_t)(row0 + rr) * D_) + lane;
#pragma unroll
            for (int j = 0; j < 4; ++j) {
                u32x2 w; w.x = pk2(v[rr][j].x * rstd * gv[j].x, v[rr][j].y * rstd * gv[j].y); w.y = pk2(v[rr][j].z * rstd * gv[j].z, v[rr][j].w * rstd * gv[j].w);
                o[64 * j] = w;
            }
        }
    }
}

DI int lds_byte(int r, int c) { const int st = (r >> 4) * 2 + (c >> 5), rr = r & 15, cc = c & 31, ob = rr * 64 + cc * 2; return st * 1024 + (ob ^ (((ob >> 9) & 1) << 5)); }
DI int perm32(int rho) { const int n = rho >> 4, i = rho & 15; return 8 * (i >> 2) + 4 * n + (i & 3); }
DI void stage_rc(int b, int& R, int& C) { const int st = b / 1024, sb = b % 1024, swz = sb ^ (((sb >> 9) & 1) << 5); R = (st >> 1) * 16 + swz / 64; C = (st & 1) * 32 + (swz % 64) / 2; }

DI bool tile_order(int i, int G, int c, int nM, int nN, int& pm, int& pn) {
    const long L = (long)i * G + c; const int nwg = nM * nN; if (L >= nwg) return false;
    int wgid = (int)L; { const int q = nwg / 8, r = nwg % 8, xcd = wgid % 8, off = wgid / 8; wgid = (xcd < r ? xcd * (q + 1) : r * (q + 1) + (xcd - r) * q) + off; }
    const int nig = 8 * nN, gid = wgid / nig, fm = gid * 8, gsz = (nM - fm) < 8 ? (nM - fm) : 8;
    pm = fm + ((wgid % nig) % gsz); pn = (wgid % nig) / gsz; return true;
}

enum { EPI_PROJ = 0, EPI_RESID = 1, EPI_BF16 = 2, EPI_GLU = 3, EPI_RESIDN = 4 };
struct EpiArgs { bf16_t* ob; int ldo; bf16_t* vt; const float* resid; float* of; const float* lb; const float* cw; const float* cb; bf16_t* halo; float* ssqp; unsigned* cnt; const float* gn; bf16_t* hn; };

DI void epi_resid(const f32x4 (&acc)[2][2][4][2], const float* __restrict__ resid, float* __restrict__ of, int brow, int bcol, int wr, int wc, int fr, int fq) {
#pragma unroll
    for (int ai = 0; ai < 2; ++ai)
#pragma unroll
        for (int m = 0; m < 4; ++m) {
            const size_t ro = (size_t)(brow + ai * 128 + wr * 64 + m * 16 + fr) * D_ + bcol + wc * 32 + 8 * fq;
            f32x4 r[2][2];
#pragma unroll
            for (int bj = 0; bj < 2; ++bj)
#pragma unroll
                for (int n = 0; n < 2; ++n) r[bj][n] = *(const f32x4*)(resid + ro + bj * 128 + n * 4);
#pragma unroll
            for (int bj = 0; bj < 2; ++bj)
#pragma unroll
                for (int n = 0; n < 2; ++n) *(f32x4*)(of + ro + bj * 128 + n * 4) = r[bj][n] + acc[ai][bj][m][n];
        }
}

DI void epi_resid_norm(f32x4 (&acc)[2][2][4][2], const float* __restrict__ resid, float* __restrict__ of, bf16_t* __restrict__ hn, const float* __restrict__ gn,
                       float* ssqp, unsigned* cnt, int brow, int bcol, int wr, int wc, int fr, int fq) {
    const int pn = bcol >> 8;
#pragma unroll
    for (int ai = 0; ai < 2; ++ai)
#pragma unroll
        for (int m = 0; m < 4; ++m) {
            const int row = brow + ai * 128 + wr * 64 + m * 16 + fr;
            const unsigned ro = (unsigned)(row * D_ + bcol + wc * 32 + 8 * fq);
            f32x4 r[2][2];
#pragma unroll
            for (int bj = 0; bj < 2; ++bj)
#pragma unroll
                for (int n = 0; n < 2; ++n) r[bj][n] = *(const f32x4*)(resid + ro + bj * 128 + n * 4);
            float ss = 0.f;
#pragma unroll
            for (int bj = 0; bj < 2; ++bj)
#pragma unroll
                for (int n = 0; n < 2; ++n) {
                    const f32x4 v = r[bj][n] + acc[ai][bj][m][n];
                    *(f32x4*)(of + ro + bj * 128 + n * 4) = v;
                    acc[ai][bj][m][n] = v;
                    ss += (v.x * v.x + v.y * v.y) + (v.z * v.z + v.w * v.w);
                }
            ss += shx(ss, 16); ss += shx(ss, 32);
            if (fq == 0) __hip_atomic_store(ssqp + (unsigned)(row * 16 + pn * 4 + wc), ss, __ATOMIC_RELAXED, __HIP_MEMORY_SCOPE_AGENT);
            if (m & 1) __builtin_amdgcn_sched_barrier(0);
        }
    asm volatile("s_waitcnt vmcnt(0)" ::: "memory");
    __builtin_amdgcn_s_barrier();
    if (threadIdx.x == 0) {
        unsigned* c = cnt + (brow >> 8);
        (void)__hip_atomic_fetch_add(c, 1u, __ATOMIC_RELAXED, __HIP_MEMORY_SCOPE_AGENT);
        unsigned sp = 0;
        while (__hip_atomic_load(c, __ATOMIC_RELAXED, __HIP_MEMORY_SCOPE_AGENT) < 4u) { __builtin_amdgcn_s_sleep(1); if (++sp > (1u << 24)) break; }
    }
    __builtin_amdgcn_s_barrier();
    asm volatile("" ::: "memory");
#pragma unroll
    for (int ai = 0; ai < 2; ++ai)
#pragma unroll
        for (int m = 0; m < 4; ++m) {
            const int row = brow + ai * 128 + wr * 64 + m * 16 + fr;
            const float* sp4 = ssqp + (unsigned)(row * 16 + 4 * fq);
            const float sa = __hip_atomic_load(sp4, __ATOMIC_RELAXED, __HIP_MEMORY_SCOPE_AGENT), sb = __hip_atomic_load(sp4 + 1, __ATOMIC_RELAXED, __HIP_MEMORY_SCOPE_AGENT);
            const float sc = __hip_atomic_load(sp4 + 2, __ATOMIC_RELAXED, __HIP_MEMORY_SCOPE_AGENT), sd = __hip_atomic_load(sp4 + 3, __ATOMIC_RELAXED, __HIP_MEMORY_SCOPE_AGENT);
            float st = (sa + sb) + (sc + sd);
            st += shx(st, 16); st += shx(st, 32);
            const float rs = 1.0f / sqrtf(st * (1.f / D_) + EPS);
#pragma unroll
            for (int bj = 0; bj < 2; ++bj) {
                const int col = bcol + bj * 128 + wc * 32 + 8 * fq;
                const f32x4 g0 = *(const f32x4*)(gn + col), g1 = *(const f32x4*)(gn + col + 4);
                const f32x4 v0 = acc[ai][bj][m][0] * rs * g0, v1 = acc[ai][bj][m][1] * rs * g1;
                u32x4 w; w.x = pk2(v0.x, v0.y); w.y = pk2(v0.z, v0.w); w.z = pk2(v1.x, v1.y); w.w = pk2(v1.z, v1.w);
                *(u32x4*)(hn + (unsigned)(row * D_ + col)) = w;
            }
        }
}

DI void epi_store_bf16(const f32x4 (&acc)[2][2][4][2], bf16_t* __restrict__ ob, int ldo, int brow, int bcol, int wr, int wc, int fr, int fq) {
#pragma unroll
    for (int ai = 0; ai < 2; ++ai)
#pragma unroll
        for (int m = 0; m < 4; ++m) {
            bf16_t* rp = ob + (size_t)(brow + ai * 128 + wr * 64 + m * 16 + fr) * ldo + bcol + wc * 32 + 8 * fq;
#pragma unroll
            for (int bj = 0; bj < 2; ++bj)
#pragma unroll
                for (int n = 0; n < 2; ++n) { const f32x4 v = acc[ai][bj][m][n]; u32x2 w; w.x = pk2(v.x, v.y); w.y = pk2(v.z, v.w); *(u32x2*)(rp + bj * 128 + n * 4) = w; }
        }
}
DI float dpp_quad_bcast(float x, int k) {
    const int xi = __builtin_bit_cast(int, x);
    int r;
    if (k == 0) r = __builtin_amdgcn_update_dpp(xi, xi, 0x00, 0xf, 0xf, true);
    else if (k == 1) r = __builtin_amdgcn_update_dpp(xi, xi, 0x55, 0xf, 0xf, true);
    else if (k == 2) r = __builtin_amdgcn_update_dpp(xi, xi, 0xAA, 0xf, 0xf, true);
    else r = __builtin_amdgcn_update_dpp(xi, xi, 0xFF, 0xf, 0xf, true);
    return __builtin_bit_cast(float, r);
}
DI void epi_store_vt(const f32x4 (&acc)[2][2][4][2], bf16_t* __restrict__ vt, int brow, int bcol, int wr, int wc, int fr, int fq) {
    const int qi = fr & 3, qa = fr >> 2;
#pragma unroll
    for (int ai = 0; ai < 2; ++ai)
#pragma unroll
        for (int m = 0; m < 4; ++m) {
            const int row = brow + ai * 128 + wr * 64 + m * 16 + 4 * qa, b = row >> 13, s = row & 8191;
#pragma unroll
            for (int bj = 0; bj < 2; ++bj)
#pragma unroll
                for (int n = 0; n < 2; ++n) {
                    const f32x4 v = acc[ai][bj][m][n];
                    float o[4];
#pragma unroll
                    for (int k = 0; k < 4; ++k) {
                        const float t0 = dpp_quad_bcast(v.x, k), t1 = dpp_quad_bcast(v.y, k), t2 = dpp_quad_bcast(v.z, k), t3 = dpp_quad_bcast(v.w, k);
                        o[k] = qi == 0 ? t0 : (qi == 1 ? t1 : (qi == 2 ? t2 : t3));
                    }
                    const int vc = bcol - 1024 + bj * 128 + wc * 32 + 8 * fq + 4 * n + qi, hh = vc >> 7, vd = vc & 127;
                    u32x2 w; w.x = pk2(o[0], o[1]); w.y = pk2(o[2], o[3]);
                    *(u32x2*)(vt + (unsigned)(((b * 4 + hh) * 128 + vd) * S_ + s)) = w;
                }
        }
}
DI void epi_store_plane(const f32x4 (&acc)[2][2][4][2], bf16_t* __restrict__ plane, int wr, int wc, int fr, int fq) {
#pragma unroll
    for (int ai = 0; ai < 2; ++ai)
#pragma unroll
        for (int m = 0; m < 4; ++m) {
            bf16_t* rp = plane + (size_t)(ai * 128 + wr * 64 + m * 16 + fr) * 128 + wc * 32 + 8 * fq;
#pragma unroll
            for (int bj = 0; bj < 2; ++bj) { const f32x4 v0 = acc[ai][bj][m][0], v1 = acc[ai][bj][m][1];
                u32x4 w; w.x = pk2(v0.x, v0.y); w.y = pk2(v0.z, v0.w); w.z = pk2(v1.x, v1.y); w.w = pk2(v1.z, v1.w); *(u32x4*)(rp + (size_t)bj * S_ * 128) = w; }
        }
}
DI void epi_store_gate(const f32x4 (&acc)[2][2][4][2], bf16_t* __restrict__ plane, const float* __restrict__ lbt, int wr, int wc, int fr, int fq) {
#pragma unroll
    for (int bj = 0; bj < 2; ++bj)
#pragma unroll
        for (int n = 0; n < 2; ++n) {
            const int cl = bj * 128 + wc * 32 + 8 * fq + 4 * n;
            const f32x4 lb4 = *(const f32x4*)(lbt + cl);
            const float ll[4] = {lb4.x, lb4.y, lb4.z, lb4.w};
#pragma unroll
            for (int ai = 0; ai < 2; ++ai)
#pragma unroll
                for (int m = 0; m < 4; ++m) {
                    const f32x4 v = acc[ai][bj][m][n];
                    const float zz[4] = {v.x, v.y, v.z, v.w};
                    float lf[4];
#pragma unroll
                    for (int e = 0; e < 4; ++e) {
                        const float z = fminf(zz[e], 80.f);
                        const float ez = __builtin_amdgcn_exp2f(z * LOG2E);
                        const float ls = z - LN2 * __builtin_amdgcn_logf(1.f + ez);
                        const float ep = fminf(__builtin_amdgcn_rcpf(ez), 1.0686475e13f);
                        lf[e] = fminf(ls + LN2 * __builtin_amdgcn_logf(1.f + ll[e] * ep), 0.f);
                    }
                    u32x2 w; w.x = pk2(lf[0], lf[1]); w.y = pk2(lf[2], lf[3]);
                    *(u32x2*)(plane + (size_t)bj * S_ * 128 + (size_t)(ai * 128 + wr * 64 + m * 16 + fr) * 128 + wc * 32 + 8 * fq + 4 * n) = w;
                }
        }
}

template <int N> DI float dpp_ror(float x) { return __builtin_bit_cast(float, __builtin_amdgcn_update_dpp(__builtin_bit_cast(int, x), __builtin_bit_cast(int, x), 0x120 + N, 0xf, 0xf, true)); }
DI float dpp_from_prev(float x) { return __builtin_bit_cast(float, __builtin_amdgcn_update_dpp(__builtin_bit_cast(int, x), __builtin_bit_cast(int, x), 0x121, 0xf, 0xf, true)); }
DI float dpp_from_next(float x) { return __builtin_bit_cast(float, __builtin_amdgcn_update_dpp(__builtin_bit_cast(int, x), __builtin_bit_cast(int, x), 0x12f, 0xf, 0xf, true)); }
DI void epi_glu(const f32x4 (&acc)[2][2][4][2], bf16_t* __restrict__ act, bf16_t* __restrict__ halo, const float* __restrict__ cw, const float* __restrict__ cb,
                int brow, int bcol, int wr, int wc, int fr, int fq) {
    const int jt = (bcol >> 8) * 128;
#pragma unroll
    for (int n = 0; n < 2; ++n) {
        const int cl = wc * 32 + 8 * fq + 4 * n;
        f32x4 w[2][3], bb[2];
#pragma unroll
        for (int hf = 0; hf < 2; ++hf) {
#pragma unroll
            for (int k = 0; k < 3; ++k) w[hf][k] = *(const f32x4*)(cw + (size_t)k * DUP + hf * DFF + jt + cl);
            bb[hf] = *(const f32x4*)(cb + hf * DFF + jt + cl);
        }
#pragma unroll
        for (int ai = 0; ai < 2; ++ai) {
            const int row0 = brow + ai * 128 + wr * 64;
#pragma unroll
            for (int m = 0; m < 4; ++m) {
                const int rl = 4 * fr + m;
                f32x4 cv[2];
#pragma unroll
                for (int hf = 0; hf < 2; ++hf) {
                    f32x4 p, q;
#pragma unroll
                    for (int e = 0; e < 4; ++e) {
                        p[e] = m > 0 ? acc[ai][hf][m > 0 ? m - 1 : 0][n][e] : dpp_from_prev(acc[ai][hf][3][n][e]);
                        q[e] = m < 3 ? acc[ai][hf][m < 3 ? m + 1 : 3][n][e] : dpp_from_next(acc[ai][hf][0][n][e]);
                    }
                    cv[hf] = w[hf][0] * p + w[hf][1] * acc[ai][hf][m][n] + w[hf][2] * q + bb[hf];
                }
                if (rl != 0 && rl != 63) {
                    float o[4];
#pragma unroll
                    for (int e = 0; e < 4; ++e) { const float a = cv[0][e]; o[e] = a * __builtin_amdgcn_rcpf(1.f + fexp(-a)) * cv[1][e]; }
                    u32x2 ww; ww.x = pk2(o[0], o[1]); ww.y = pk2(o[2], o[3]);
                    *(u32x2*)(act + (size_t)(row0 + rl) * DFF + jt + cl) = ww;
                }
                if (rl < 2 || rl > 61) {
                    const int hr = rl < 2 ? rl : rl - 60;
                    bf16_t* hp = halo + ((size_t)(row0 >> 6) * 4 + hr) * DUP + jt + cl;
#pragma unroll
                    for (int hf = 0; hf < 2; ++hf) { const f32x4 v = acc[ai][hf][m][n]; u32x2 ww; ww.x = pk2(v.x, v.y); ww.y = pk2(v.z, v.w); *(u32x2*)(hp + hf * DFF) = ww; }
                }
                __builtin_amdgcn_sched_barrier(0);
            }
        }
    }
}

DI void phase_glu_fixup(const bf16_t* __restrict__ halo, bf16_t* __restrict__ act, const float* __restrict__ cw, const float* __restrict__ cb) {
    const int gt = obid() * NTHREADS + otid();
    constexpr int NCG = DFF / 8;
    for (int unit = gt; unit < 512 * 2 * NCG; unit += ogdim() * NTHREADS) {
        const int cgp = unit % NCG, rs = unit / NCG, strip = rs >> 1, last = rs & 1, j0 = cgp * 8;
        const int t = strip * 64 + (last ? 63 : 0);
        const bool edge = last ? ((t & 8191) == 8191) : ((t & 8191) == 0);
        const bf16_t* hp = last ? halo + ((size_t)strip * 4 + 2) * DUP : (edge ? halo : halo + ((size_t)(strip - 1) * 4 + 3) * DUP);
        const bf16_t* hc = halo + ((size_t)strip * 4 + (last ? 3 : 0)) * DUP;
        const bf16_t* hn = last ? (edge ? halo : halo + ((size_t)(strip + 1) * 4 + 0) * DUP) : halo + ((size_t)strip * 4 + 1) * DUP;
        const bool zp = !last && edge, zn = last && edge;
        float res[8];
#pragma unroll
        for (int half = 0; half < 2; ++half) { (void)half; }
        u32x4 P[2], C[2], N[2];
#pragma unroll
        for (int hf = 0; hf < 2; ++hf) { P[hf] = *(const u32x4*)(hp + hf * DFF + j0); C[hf] = *(const u32x4*)(hc + hf * DFF + j0); N[hf] = *(const u32x4*)(hn + hf * DFF + j0); }
        float cvv[2][8];
#pragma unroll
        for (int hf = 0; hf < 2; ++hf) {
            const unsigned pw[4] = {P[hf].x, P[hf].y, P[hf].z, P[hf].w}, cwd[4] = {C[hf].x, C[hf].y, C[hf].z, C[hf].w}, nw[4] = {N[hf].x, N[hf].y, N[hf].z, N[hf].w};
#pragma unroll
            for (int e = 0; e < 8; ++e) {
                const float pv = zp ? 0.f : ((e & 1) ? bfhi(pw[e >> 1]) : bflo(pw[e >> 1]));
                const float cc = (e & 1) ? bfhi(cwd[e >> 1]) : bflo(cwd[e >> 1]);
                const float nv = zn ? 0.f : ((e & 1) ? bfhi(nw[e >> 1]) : bflo(nw[e >> 1]));
                const int col = hf * DFF + j0 + e;
                cvv[hf][e] = cw[col] * pv + cw[DUP + col] * cc + cw[2 * DUP + col] * nv + cb[col];
            }
        }
#pragma unroll
        for (int e = 0; e < 8; ++e) { const float a = cvv[0][e]; res[e] = a * __builtin_amdgcn_rcpf(1.f + fexp(-a)) * cvv[1][e]; }
        u32x4 o; o.x = pk2(res[0], res[1]); o.y = pk2(res[2], res[3]); o.z = pk2(res[4], res[5]); o.w = pk2(res[6], res[7]);
        *(u32x4*)(act + (size_t)t * DFF + j0) = o;
    }
}

template <int EPI>
DI void gemm_epilogue(f32x4 (&acc)[2][2][4][2], const EpiArgs& ea, int brow, int bcol, int wr, int wc, int fr_, int fq_) {
    int fr = fr_, fq = fq_;
    asm volatile("" : "+v"(fr), "+v"(fq));
    if (EPI == EPI_RESIDN) { epi_resid_norm(acc, ea.resid, ea.of, ea.hn, ea.gn, ea.ssqp, ea.cnt, brow, bcol, wr, wc, fr, fq); return; }
    if (EPI == EPI_RESID) { epi_resid(acc, ea.resid, ea.of, brow, bcol, wr, wc, fr, fq); return; }
    if (EPI == EPI_BF16) { epi_store_bf16(acc, ea.ob, ea.ldo, brow, bcol, wr, wc, fr, fq); return; }
    if (EPI == EPI_GLU) { epi_glu(acc, ea.ob, ea.halo, ea.cw, ea.cb, brow, bcol, wr, wc, fr, fq); return; }
    if (bcol >= 1024 && bcol < 1536) epi_store_vt(acc, ea.vt, brow, bcol, wr, wc, fr, fq);
    else {
        const int g = bcol >> 9, hb = (bcol >> 7) & 3, b = brow >> 13, s0 = brow & 8191;
        bf16_t* plane = ea.ob + pidx(g, b, hb, s0);
        if (bcol >= 2048 && bcol < 3072) epi_store_gate(acc, plane, ea.lb + (bcol - 2048), wr, wc, fr, fq);
        else epi_store_plane(acc, plane, wr, wc, fr, fq);
    }
}

template <int EPI>
DI void gemm_phase(const bf16_t* __restrict__ A, const bf16_t* __restrict__ Bt, int M, int N, int K, const EpiArgs& ea) {
    extern __shared__ __attribute__((aligned(16))) char shm[];
#define SA(b, h) (shm + ((b) * 2 + (h)) * 16384)
#define SB(b, h) (shm + (4 + (b) * 2 + (h)) * 16384)
#define STAGE(P, BASE, br, kt) do { const unsigned _g = (unsigned)(br) * (unsigned)K + (unsigned)(kt) * 64u; \
    __builtin_amdgcn_global_load_lds((const unsigned*)((BASE) + (_g + toff0)), (unsigned*)((P) + tid16), 16, 0, 0); \
    __builtin_amdgcn_global_load_lds((const unsigned*)((BASE) + (_g + toff1)), (unsigned*)((P) + tid16 + 8192), 16, 0, 0); } while (0)
#define STAGEB(P, BASE, br, kt) do { const unsigned _g = (unsigned)(br) * (unsigned)K + (unsigned)(kt) * 64u; \
    __builtin_amdgcn_global_load_lds((const unsigned*)((BASE) + (_g + toffb0)), (unsigned*)((P) + tid16), 16, 0, 0); \
    __builtin_amdgcn_global_load_lds((const unsigned*)((BASE) + (_g + toffb1)), (unsigned*)((P) + tid16 + 8192), 16, 0, 0); } while (0)
#define LDA(dst, b, h) _Pragma("unroll") for (int m = 0; m < 4; ++m) _Pragma("unroll") for (int k = 0; k < 2; ++k) \
    dst[m][k] = *reinterpret_cast<const bf16x8*>(SA(b, h) + lds_byte(wr * 64 + m * 16 + fr, k * 32 + fq * 8))
#define LDB(dst, b, h) _Pragma("unroll") for (int n = 0; n < 2; ++n) _Pragma("unroll") for (int k = 0; k < 2; ++k) \
    dst[n][k] = *reinterpret_cast<const bf16x8*>(SB(b, h) + lds_byte(wc * 32 + n * 16 + fr, k * 32 + fq * 8))
#define MMA(ai, bj, At, Bt_) do { __builtin_amdgcn_s_setprio(1); \
    _Pragma("unroll") for (int m = 0; m < 4; ++m) _Pragma("unroll") for (int n = 0; n < 2; ++n) _Pragma("unroll") for (int k = 0; k < 2; ++k) \
      acc[ai][bj][m][n] = __builtin_amdgcn_mfma_f32_16x16x32_bf16(Bt_[n][k], At[m][k], acc[ai][bj][m][n], 0, 0, 0); \
    __builtin_amdgcn_s_setprio(0); } while (0)
#define WAIT_V(n) asm volatile("s_waitcnt vmcnt(" #n ")" ::: "memory")
#define WAIT_L(n) asm volatile("s_waitcnt lgkmcnt(" #n ")" ::: "memory")
#define BAR __builtin_amdgcn_s_barrier()
#define SCHED __builtin_amdgcn_sched_barrier(0)
    const int nM = M / 256, nN = N / 256;
    const int nt = K / 64;
    int pm, pn;
    if (!tile_order(0, ogdim(), obid(), nM, nN, pm, pn)) return;
    int brow = pm * 256, bcol = pn * 256, nbrow = brow, nbcol = bcol;
    bool hn = tile_order(1, ogdim(), obid(), nM, nN, pm, pn);
    if (hn) { nbrow = pm * 256; nbcol = pn * 256; }
    const int tidx = otid();
    const int wid = __builtin_amdgcn_readfirstlane(tidx >> 6), lane = tidx & 63, wr = wid >> 2, wc = wid & 3, fr = lane & 15, fq = lane >> 4;
    const int tid16 = tidx * 16;
    unsigned toff0, toff1;
    unsigned toffb0, toffb1;
    { int r_, c_; stage_rc(tid16, r_, c_); const int ra0 = EPI == EPI_GLU ? (r_ & ~63) + 4 * (r_ & 15) + ((r_ >> 4) & 3) : r_;
      toff0 = (unsigned)(ra0 * K + c_); toffb0 = (unsigned)(((r_ & ~31) + perm32(r_ & 31)) * K + c_);
      stage_rc(tid16 + 8192, r_, c_); const int ra1 = EPI == EPI_GLU ? (r_ & ~63) + 4 * (r_ & 15) + ((r_ >> 4) & 3) : r_;
      toff1 = (unsigned)(ra1 * K + c_); toffb1 = (unsigned)(((r_ & ~31) + perm32(r_ & 31)) * K + c_); }
    f32x4 acc[2][2][4][2];
#pragma unroll
    for (int a = 0; a < 2; ++a)
#pragma unroll
        for (int b = 0; b < 2; ++b)
#pragma unroll
            for (int c = 0; c < 4; ++c)
#pragma unroll
                for (int d = 0; d < 2; ++d) acc[a][b][c][d] = (f32x4){0.f, 0.f, 0.f, 0.f};
    bf16x8 At[4][2], B0[2][2], B1[2][2];
    STAGEB(SB(0, 0), Bt, bcol, 0); STAGEB(SB(0, 1), Bt, bcol + 128, 0); STAGE(SA(0, 0), A, brow, 0); STAGE(SA(0, 1), A, brow + 128, 0);
    if (wr == 1) BAR;
    WAIT_V(2); BAR;
    STAGEB(SB(1, 0), Bt, bcol, 1); STAGE(SA(1, 0), A, brow, 1); STAGEB(SB(1, 1), Bt, bcol + 128, 1);
    WAIT_V(6); BAR;
#pragma unroll 1
    for (int it = 0;; ++it) {
#pragma unroll 1
        for (int t = 0; t < nt; t += 2) {
            const bool wrap = (t + 2 >= nt);
            const int r2 = wrap ? nbrow : brow, c2 = wrap ? nbcol : bcol, k2 = wrap ? 0 : t + 2, k3 = k2 + 1;
            LDB(B0, 0, 0); LDB(B1, 0, 1); SCHED; LDA(At, 0, 0); STAGE(SA(1, 1), A, brow + 128, t + 1);
            WAIT_V(8); WAIT_L(0); BAR; MMA(0, 0, At, B0); MMA(0, 1, At, B1); BAR; SCHED;
            LDA(At, 0, 1); STAGEB(SB(0, 0), Bt, c2, k2); STAGEB(SB(0, 1), Bt, c2 + 128, k2); STAGE(SA(0, 0), A, r2, k2);
            WAIT_V(8); WAIT_L(0); BAR; MMA(1, 0, At, B0); MMA(1, 1, At, B1); BAR; SCHED;
            LDB(B0, 1, 0); LDB(B1, 1, 1); SCHED; LDA(At, 1, 0); STAGE(SA(0, 1), A, r2 + 128, k2);
            WAIT_V(8); WAIT_L(0); BAR; MMA(0, 0, At, B0); MMA(0, 1, At, B1); BAR; SCHED;
            LDA(At, 1, 1); STAGEB(SB(1, 0), Bt, c2, k3); STAGEB(SB(1, 1), Bt, c2 + 128, k3); STAGE(SA(1, 0), A, r2, k3);
            WAIT_V(8); WAIT_L(0); BAR; MMA(1, 0, At, B0); MMA(1, 1, At, B1); BAR; SCHED;
        }
        if (wr == 0) BAR;
        gemm_epilogue<EPI>(acc, ea, brow, bcol, wr, wc, fr, fq);
        if (!hn) break;
#pragma unroll
        for (int a = 0; a < 2; ++a)
#pragma unroll
            for (int b = 0; b < 2; ++b)
#pragma unroll
                for (int c = 0; c < 4; ++c)
#pragma unroll
                    for (int d = 0; d < 2; ++d) acc[a][b][c][d] = (f32x4){0.f, 0.f, 0.f, 0.f};
        brow = nbrow; bcol = nbcol;
        hn = tile_order(it + 2, ogdim(), obid(), nM, nN, pm, pn);
        if (hn) { nbrow = pm * 256; nbcol = pn * 256; }
        if (wr == 1) BAR;
    }
    WAIT_V(0);
    __syncthreads();
#undef SA
#undef SB
#undef STAGE
#undef STAGEB
#undef LDA
#undef LDB
#undef MMA
}

DI void phase_qkprep(bf16_t* proj, const float* __restrict__ rope, const float* __restrict__ kg) {
    const int tid = otid(), wave = tid >> 6, lane = tid & 63;
    const int grp = lane >> 2, tsel = grp >> 3, hc = grp & 7, qq = lane & 3;
    float g1[8], g2[8];
#pragma unroll
    for (int e = 0; e < 8; ++e) { g1[e] = kg[qq * 8 + e]; g2[e] = kg[32 + qq * 8 + e]; }
    for (int t0 = (obid() * NWAVES + wave) * 8; t0 < T_; t0 += ogdim() * NWAVES * 8) {
        u32x4 r1[4], r2[4]; f32x4 c0[4], c1[4], s0[4], s1[4];
#pragma unroll
        for (int u = 0; u < 4; ++u) {
            const int t = t0 + 2 * u + tsel;
            const bf16_t* pp = proj + pidx(1, t >> 13, hc >> 1, t & 8191) + (hc & 1) * 64 + qq * 8;
            r1[u] = *(const u32x4*)pp; r2[u] = *(const u32x4*)(pp + 32);
            const float* rp = rope + (size_t)t * 64 + qq * 8;
            c0[u] = *(const f32x4*)rp; c1[u] = *(const f32x4*)(rp + 4); s0[u] = *(const f32x4*)(rp + 32); s1[u] = *(const f32x4*)(rp + 36);
        }
#pragma unroll
        for (int u = 0; u < 4; ++u) {
            const int t = t0 + 2 * u + tsel;
            bf16_t* pp = proj + pidx(1, t >> 13, hc >> 1, t & 8191) + (hc & 1) * 64 + qq * 8;
            float x1[8], x2[8];
            x1[0] = bflo(r1[u].x); x1[1] = bfhi(r1[u].x); x1[2] = bflo(r1[u].y); x1[3] = bfhi(r1[u].y); x1[4] = bflo(r1[u].z); x1[5] = bfhi(r1[u].z); x1[6] = bflo(r1[u].w); x1[7] = bfhi(r1[u].w);
            x2[0] = bflo(r2[u].x); x2[1] = bfhi(r2[u].x); x2[2] = bflo(r2[u].y); x2[3] = bfhi(r2[u].y); x2[4] = bflo(r2[u].z); x2[5] = bfhi(r2[u].z); x2[6] = bflo(r2[u].w); x2[7] = bfhi(r2[u].w);
            float ss = 0.f;
#pragma unroll
            for (int e = 0; e < 8; ++e) ss += x1[e] * x1[e] + x2[e] * x2[e];
            ss += shx(ss, 1); ss += shx(ss, 2);
            const float rstd = 1.0f / sqrtf(ss * (1.f / 64.f) + EPS);
            const float cs[8] = {c0[u].x, c0[u].y, c0[u].z, c0[u].w, c1[u].x, c1[u].y, c1[u].z, c1[u].w}, sn[8] = {s0[u].x, s0[u].y, s0[u].z, s0[u].w, s1[u].x, s1[u].y, s1[u].z, s1[u].w};
            float y1[8], y2[8];
#pragma unroll
            for (int e = 0; e < 8; ++e) {
                const float a = x1[e] * rstd * g1[e], bq = x2[e] * rstd * g2[e];
                y1[e] = a * cs[e] - bq * sn[e]; y2[e] = bq * cs[e] + a * sn[e];
            }
            u32x4 o1, o2;
            o1.x = pk2(y1[0], y1[1]); o1.y = pk2(y1[2], y1[3]); o1.z = pk2(y1[4], y1[5]); o1.w = pk2(y1[6], y1[7]);
            o2.x = pk2(y2[0], y2[1]); o2.y = pk2(y2[2], y2[3]); o2.z = pk2(y2[4], y2[5]); o2.w = pk2(y2[6], y2[7]);
            *(u32x4*)pp = o1; *(u32x4*)(pp + 32) = o2;
        }
    }
}

constexpr int KS_BYTES = 64 * 256, VS_BYTES = 128 * 128, KV_BYTES = KS_BYTES + VS_BYTES;

template <bool SHIFT>
DI void phase_attention(const bf16_t* proj, const bf16_t* vt, bf16_t* y, const float* dog, float lam, float oscale, float mb, const float* __restrict__ rope, const float* __restrict__ qgn) {
    extern __shared__ __attribute__((aligned(16))) char shm[];
#pragma unroll 1
    for (int item = obid(); item < NB * 4 * 32; item += ogdim()) {
        const int tid = otid();
        const int wave = __builtin_amdgcn_readfirstlane(tid >> 6), lane = tid & 63, r = lane & 31, hh = lane >> 5;
        const int c = wave & 1, qg = wave >> 1;
        const int pair = ((item >> 8) << 3) | (item & 7), qb = (item >> 3) & 31, b = pair >> 2, h = pair & 3;
        const int q0 = qb * 256 + qg * 64;
        bf16x8 qf[2][4];
#pragma unroll
        for (int blk = 0; blk < 2; ++blk)
#pragma unroll
            for (int ks = 0; ks < 4; ++ks) qf[blk][ks] = *(const bf16x8*)(proj + (unsigned)(pidx(0, b, h, q0 + blk * 32 + r) + c * 64 + ks * 16 + hh * 8));
#pragma unroll
        for (int blk = 0; blk < 2; ++blk) {
            float x[4][8]; float ss = 0.f;
#pragma unroll
            for (int ks = 0; ks < 4; ++ks) {
                const u32x4 w = __builtin_bit_cast(u32x4, qf[blk][ks]);
                x[ks][0] = bflo(w.x); x[ks][1] = bfhi(w.x); x[ks][2] = bflo(w.y); x[ks][3] = bfhi(w.y); x[ks][4] = bflo(w.z); x[ks][5] = bfhi(w.z); x[ks][6] = bflo(w.w); x[ks][7] = bfhi(w.w);
#pragma unroll
                for (int e = 0; e < 8; ++e) ss += x[ks][e] * x[ks][e];
            }
            ss += shx(ss, 32);
            const float rstd = 1.0f / sqrtf(ss * (1.f / 64.f) + EPS);
            const float* rp = rope + (size_t)(b * S_ + q0 + blk * 32 + r) * 64 + hh * 8;
#pragma unroll
            for (int ks = 0; ks < 2; ++ks) {
                const f32x4 ca = *(const f32x4*)(rp + ks * 16), cb2 = *(const f32x4*)(rp + ks * 16 + 4), sa = *(const f32x4*)(rp + 32 + ks * 16), sb2 = *(const f32x4*)(rp + 32 + ks * 16 + 4);
                const f32x4 ga = *(const f32x4*)(qgn + ks * 16 + hh * 8), gb = *(const f32x4*)(qgn + ks * 16 + hh * 8 + 4), gc = *(const f32x4*)(qgn + 32 + ks * 16 + hh * 8), gd = *(const f32x4*)(qgn + 32 + ks * 16 + hh * 8 + 4);
                const float cs[8] = {ca.x, ca.y, ca.z, ca.w, cb2.x, cb2.y, cb2.z, cb2.w}, sn[8] = {sa.x, sa.y, sa.z, sa.w, sb2.x, sb2.y, sb2.z, sb2.w};
                const float g1[8] = {ga.x, ga.y, ga.z, ga.w, gb.x, gb.y, gb.z, gb.w}, g2[8] = {gc.x, gc.y, gc.z, gc.w, gd.x, gd.y, gd.z, gd.w};
                float y1[8], y2[8];
#pragma unroll
                for (int e = 0; e < 8; ++e) {
                    const float a = x[ks][e] * rstd * g1[e], bq = x[ks + 2][e] * rstd * g2[e];
                    y1[e] = (a * cs[e] - bq * sn[e]) * (0.125f * LOG2E); y2[e] = (bq * cs[e] + a * sn[e]) * (0.125f * LOG2E);
                }
                qf[blk][ks] = pack8(y1[0], y1[1], y1[2], y1[3], y1[4], y1[5], y1[6], y1[7]);
                qf[blk][ks + 2] = pack8(y2[0], y2[1], y2[2], y2[3], y2[4], y2[5], y2[6], y2[7]);
            }
        }
        f32x16 O[2][4];
#pragma unroll
        for (int blk = 0; blk < 2; ++blk)
#pragma unroll
            for (int vb = 0; vb < 4; ++vb)
#pragma unroll
                for (int i = 0; i < 16; ++i) O[blk][vb][i] = 0.f;
        float lsum[2] = {0.f, 0.f};
        unsigned ko0, ko1, vo0, vo1;
        {
            const int L0 = (2 * wave) * 64 + lane, L1 = L0 + 64;
            const int r0 = L0 >> 4, c0 = (L0 & 15) ^ (r0 & 15), r1 = L1 >> 4, c1 = (L1 & 15) ^ (r1 & 15);
            const int s0 = (r0 & ~12) | ((r0 & 4) << 1) | ((r0 & 8) >> 1), s1 = (r1 & ~12) | ((r1 & 4) << 1) | ((r1 & 8) >> 1);
            ko0 = (unsigned)(pidx(1, b, h, s0) + c0 * 8);
            ko1 = (unsigned)(pidx(1, b, h, s1) + c1 * 8);
            const int v0 = L0 >> 3, d0 = (L0 & 7) ^ ((v0 >> 1) & 7), v1 = L1 >> 3, d1 = (L1 & 7) ^ ((v1 >> 1) & 7);
            vo0 = (unsigned)(((b * 4 + h) * 128 + v0) * S_ + d0 * 8);
            vo1 = (unsigned)(((b * 4 + h) * 128 + v1) * S_ + d1 * 8);
        }
#define LOADKV(kt, buf) do { char* kb_ = shm + (buf) * KV_BYTES + (2 * wave) * 1024; char* vb_ = shm + (buf) * KV_BYTES + KS_BYTES + (2 * wave) * 1024; \
            __builtin_amdgcn_global_load_lds((const unsigned*)(proj + (ko0 + (unsigned)(kt) * (64u * 128u))), (unsigned*)(kb_), 16, 0, 0); \
            __builtin_amdgcn_global_load_lds((const unsigned*)(proj + (ko1 + (unsigned)(kt) * (64u * 128u))), (unsigned*)(kb_ + 1024), 16, 0, 0); \
            __builtin_amdgcn_global_load_lds((const unsigned*)(vt + (vo0 + (unsigned)(kt) * 64u)), (unsigned*)(vb_), 16, 0, 0); \
            __builtin_amdgcn_global_load_lds((const unsigned*)(vt + (vo1 + (unsigned)(kt) * 64u)), (unsigned*)(vb_ + 1024), 16, 0, 0); } while (0)
        __syncthreads();
        LOADKV(0, 0);
        asm volatile("s_waitcnt vmcnt(0)" ::: "memory");
        __syncthreads();
        constexpr int NT = S_ / 64;
#pragma unroll 1
        for (int kt = 0; kt < NT; ++kt) {
            if (kt + 1 < NT) LOADKV(kt + 1, (kt + 1) & 1);
            const char* ksb = shm + (kt & 1) * KV_BYTES; const char* vsb = ksb + KS_BYTES;
#pragma unroll 1
            for (int kb = 0; kb < 2; ++kb) {
                bf16x8 P[2][2];
                const int rho = kb * 32 + r;
                const char* krow_p = ksb + rho * 256 + c * 128;
                int ksw = r & 15, vsw = (r >> 1) & 7;
                asm volatile("" : "+v"(ksw), "+v"(vsw));
                bf16x8 kf[4];
#pragma unroll
                for (int ks = 0; ks < 4; ++ks) kf[ks] = *(const bf16x8*)(ksb + rho * 256 + (((c * 8 + ks * 2 + hh) ^ ksw) * 16));
                (void)krow_p;
                f32x16 X0, X1;
#pragma unroll
                for (int i = 0; i < 16; ++i) { X0[i] = 0.f; X1[i] = 0.f; }
#pragma unroll
                for (int ks = 0; ks < 4; ++ks) { X0 = MFMA32(kf[ks], qf[0][ks], X0); X1 = MFMA32(kf[ks], qf[1][ks], X1); }
                __builtin_amdgcn_sched_barrier(0);
                bf16x8 va[2][2];
                { const char* vrow_p = vsb + r * 128;
                  va[0][0] = *(const bf16x8*)(vrow_p + (((kb * 4 + hh) ^ vsw) * 16));
                  va[0][1] = *(const bf16x8*)(vrow_p + (((kb * 4 + 2 + hh) ^ vsw) * 16)); }
                {
                    float ps = 0.f;
#pragma unroll
                    for (int i = 0; i < 16; ++i) { X0[i] = __builtin_amdgcn_exp2f(SHIFT ? X0[i] - mb : X0[i]); ps += X0[i]; }
                    lsum[0] += ps;
                    { const char* vrow_p = vsb + (32 + r) * 128;
                      va[1][0] = *(const bf16x8*)(vrow_p + (((kb * 4 + hh) ^ vsw) * 16));
                      va[1][1] = *(const bf16x8*)(vrow_p + (((kb * 4 + 2 + hh) ^ vsw) * 16)); }
                    P[0][0] = pack8(X0[0], X0[1], X0[2], X0[3], X0[4], X0[5], X0[6], X0[7]);
                    P[0][1] = pack8(X0[8], X0[9], X0[10], X0[11], X0[12], X0[13], X0[14], X0[15]);
                }
                __builtin_amdgcn_sched_barrier(0);
#pragma unroll
                for (int vb = 0; vb < 2; ++vb) { O[0][vb] = MFMA32(P[0][0], va[vb][0], O[0][vb]); O[0][vb] = MFMA32(P[0][1], va[vb][1], O[0][vb]); }
                bf16x8 vc0, vc1;
                {
                    float ps = 0.f;
#pragma unroll
                    for (int i = 0; i < 16; ++i) { X1[i] = __builtin_amdgcn_exp2f(SHIFT ? X1[i] - mb : X1[i]); ps += X1[i]; }
                    lsum[1] += ps;
                    vc0 = *(const bf16x8*)(vsb + (64 + r) * 128 + (((kb * 4 + hh) ^ vsw) * 16));
                    vc1 = *(const bf16x8*)(vsb + (64 + r) * 128 + (((kb * 4 + 2 + hh) ^ vsw) * 16));
                    P[1][0] = pack8(X1[0], X1[1], X1[2], X1[3], X1[4], X1[5], X1[6], X1[7]);
                    P[1][1] = pack8(X1[8], X1[9], X1[10], X1[11], X1[12], X1[13], X1[14], X1[15]);
                }
                __builtin_amdgcn_sched_barrier(0);
                const bf16x8 vd0 = *(const bf16x8*)(vsb + (96 + r) * 128 + (((kb * 4 + hh) ^ vsw) * 16));
                const bf16x8 vd1 = *(const bf16x8*)(vsb + (96 + r) * 128 + (((kb * 4 + 2 + hh) ^ vsw) * 16));
#pragma unroll
                for (int vb = 0; vb < 2; ++vb) { O[1][vb] = MFMA32(P[1][0], va[vb][0], O[1][vb]); O[1][vb] = MFMA32(P[1][1], va[vb][1], O[1][vb]); }
                __builtin_amdgcn_sched_barrier(0);
                O[0][2] = MFMA32(P[0][0], vc0, O[0][2]); O[1][2] = MFMA32(P[1][0], vc0, O[1][2]);
                O[0][2] = MFMA32(P[0][1], vc1, O[0][2]); O[1][2] = MFMA32(P[1][1], vc1, O[1][2]);
                __builtin_amdgcn_sched_barrier(0);
                O[0][3] = MFMA32(P[0][0], vd0, O[0][3]); O[1][3] = MFMA32(P[1][0], vd0, O[1][3]);
                O[0][3] = MFMA32(P[0][1], vd1, O[0][3]); O[1][3] = MFMA32(P[1][1], vd1, O[1][3]);
                __builtin_amdgcn_sched_barrier(0);
            }
            asm volatile("s_waitcnt vmcnt(0) lgkmcnt(0)" ::: "memory");
            __builtin_amdgcn_s_barrier();
            asm volatile("" ::: "memory");
        }
#undef LOADKV
        float linv[2];
#pragma unroll
        for (int blk = 0; blk < 2; ++blk) { const float l = lsum[blk] + shx(lsum[blk], 32); linv[blk] = 1.0f / l; }
        float* xch = (float*)shm + qg * (2 * 4 * 16 * 64) + lane;
#pragma unroll
        for (int blk = 0; blk < 2; ++blk)
#pragma unroll
            for (int i = 0; i < 16; ++i) {
                const float li = shl_(linv[blk], crow(i, hh));
#pragma unroll
                for (int vb = 0; vb < 4; ++vb) O[blk][vb][i] *= li;
            }
        if (c == 1) {
#pragma unroll
            for (int blk = 0; blk < 2; ++blk)
#pragma unroll
                for (int vb = 0; vb < 4; ++vb)
#pragma unroll
                    for (int i = 0; i < 16; ++i) xch[((blk * 4 + vb) * 16 + i) * 64] = O[blk][vb][i];
        }
        __syncthreads();
        if (c == 0) {
            float gv4[4];
#pragma unroll
            for (int vb = 0; vb < 4; ++vb) gv4[vb] = dog[vb * 32 + r] * oscale;
#pragma unroll
            for (int blk = 0; blk < 2; ++blk)
#pragma unroll
                for (int i = 0; i < 16; ++i) {
                    const int qrow = crow(i, hh);
                    float o[4], ss = 0.f;
#pragma unroll
                    for (int vb = 0; vb < 4; ++vb) { o[vb] = O[blk][vb][i] - lam * xch[((blk * 4 + vb) * 16 + i) * 64]; ss += o[vb] * o[vb]; }
                    ss += shx(ss, 1); ss += shx(ss, 2); ss += shx(ss, 4); ss += shx(ss, 8); ss += shx(ss, 16);
                    const float rstd = 1.0f / sqrtf(ss * (1.f / 128.f) + EPS);
                    const unsigned yo = (unsigned)((b * S_ + q0 + blk * 32 + qrow) * D_ + h * 128 + r);
#pragma unroll
                    for (int vb = 0; vb < 4; ++vb) y[yo + vb * 32] = f2bf(o[vb] * rstd * gv4[vb]);
                }
        }
    }
}

constexpr int REL_STRIDE = 132;
constexpr int HL_REL = 0;
constexpr int HL_K = 67584;
constexpr int HL_VT = HL_K + 34816;
constexpr int HL_SEG = HL_VT + 34816;
constexpr int HL_SSQ = HL_SEG + 2048;
constexpr int HROW = 272;

template <int MODE>
DI void hgrn_cumsum(const bf16_t* proj, const float* lb, int dir, int b, int h, int m, char* shm, float* dec_out) {
    const int tid = otid(), d = tid & 127, seg = tid >> 7;
    const bf16_t* zp = proj + pidx(4 + dir, b, h, m * 128 + seg * 32) + d;
    float c[32], kv[32];
#pragma unroll
    for (int i = 0; i < 32; ++i) {
        const float lf = bf2f(zp[i * 128]);
        c[i] = lf; kv[i] = 1.f - fexp(lf);
    }
    if (dir == 0) {
#pragma unroll
        for (int i = 1; i < 32; ++i) c[i] += c[i - 1];
    } else {
#pragma unroll
        for (int i = 30; i >= 0; --i) c[i] += c[i + 1];
    }
    float* segtot = (float*)(shm + HL_SEG);
    segtot[seg * 128 + d] = (dir == 0) ? c[31] : c[0];
    __syncthreads();
    const float t0 = segtot[d], t1 = segtot[128 + d], t2 = segtot[256 + d], t3 = segtot[384 + d];
    float off;
    if (dir == 0) off = (seg > 0 ? t0 : 0.f) + (seg > 1 ? t1 : 0.f) + (seg > 2 ? t2 : 0.f);
    else off = (seg < 3 ? t3 : 0.f) + (seg < 2 ? t2 : 0.f) + (seg < 1 ? t1 : 0.f);
    if (MODE == 0) {
        const float total = (t0 + t1) + (t2 + t3);
        if (seg == 0) dec_out[d] = expf(total);
        char* kt = shm + HL_K + d * HROW + seg * 64;
#pragma unroll
        for (int i = 0; i < 32; i += 8) {
            float e[8];
#pragma unroll
            for (int j = 0; j < 8; ++j) e[j] = kv[i + j] * fexp(total - (c[i + j] + off));
            *(bf16x8*)(kt + i * 2) = pack8(e[0], e[1], e[2], e[3], e[4], e[5], e[6], e[7]);
        }
    } else {
        float* rel = (float*)(shm + HL_REL);
        bf16_t* kl = (bf16_t*)(shm + HL_K);
#pragma unroll
        for (int i = 0; i < 32; ++i) {
            const int t = seg * 32 + i;
            rel[t * REL_STRIDE + d] = c[i] + off;
            kl[t * (HROW / 2) + d] = f2bf(kv[i]);
        }
    }
}

DI void hgrn_load_vt(const bf16_t* proj, int b, int h, int m, char* shm) {
    const int tid = otid(), s = tid & 127, vg = tid >> 7;
    const bf16_t* ip = proj + pidx(6, b, h, m * 128 + s) + vg * 32;
    bf16_t* vtl = (bf16_t*)(shm + HL_VT);
#pragma unroll
    for (int j = 0; j < 4; ++j) {
        const u32x4 w = *(const u32x4*)(ip + j * 8);
        const unsigned ww[4] = {w.x, w.y, w.z, w.w};
#pragma unroll
        for (int e = 0; e < 4; ++e) {
            const int v = vg * 32 + j * 8 + e * 2;
            vtl[v * (HROW / 2) + s] = (bf16_t)(ww[e] & 0xffffu);
            vtl[(v + 1) * (HROW / 2) + s] = (bf16_t)(ww[e] >> 16);
        }
    }
}

DI void phase_hgrn_pass1(const bf16_t* __restrict__ proj, const float* __restrict__ lb, bf16_t* __restrict__ states, float* __restrict__ dec) {
    extern __shared__ __attribute__((aligned(16))) char shm[];
    constexpr int P1_K1 = HL_REL, P1_SEG = HL_REL + 40960;
#pragma unroll 1
    for (int item = obid(); item < NB * 4 * 64; item += ogdim()) {
        const int tid = otid(), wave = __builtin_amdgcn_readfirstlane(tid >> 6), lane = tid & 63, r = lane & 31, hh = lane >> 5;
        const int b = item >> 8, h = (item >> 6) & 3, m = item & 63;
        const int d = tid & 127, seg = tid >> 7;
        __syncthreads();
        hgrn_load_vt(proj, b, h, m, shm);
        float c0[32], c1[32];
        {
            const bf16_t* z0 = proj + pidx(4, b, h, m * 128 + seg * 32) + d;
            const bf16_t* z1 = proj + pidx(5, b, h, m * 128 + seg * 32) + d;
#pragma unroll
            for (int i = 0; i < 32; ++i) { c0[i] = bf2f(z0[i * 128]); c1[i] = bf2f(z1[i * 128]); }
        }
        float* segtot = (float*)(shm + P1_SEG);
        {
            float s0 = 0.f, s1 = 0.f;
#pragma unroll
            for (int i = 0; i < 32; ++i) { s0 += c0[i]; s1 += c1[i]; }
            segtot[seg * 128 + d] = s0; segtot[512 + seg * 128 + d] = s1;
        }
        __syncthreads();
        {
            const float a0 = segtot[d], a1 = segtot[128 + d], a2 = segtot[256 + d], a3 = segtot[384 + d];
            const float e0 = segtot[512 + d], e1 = segtot[640 + d], e2 = segtot[768 + d], e3 = segtot[896 + d];
            float run0 = (seg < 3 ? a3 : 0.f) + (seg < 2 ? a2 : 0.f) + (seg < 1 ? a1 : 0.f);
            float run1 = (seg > 0 ? e0 : 0.f) + (seg > 1 ? e1 : 0.f) + (seg > 2 ? e2 : 0.f);
            if (seg == 0) {
                const int s0i = ((0 * 4 + b) * 4 + h) * 64 + m, s1i = ((1 * 4 + b) * 4 + h) * 64 + m;
                dec[(size_t)s0i * 128 + d] = expf((a0 + a1) + (a2 + a3));
                dec[(size_t)s1i * 128 + d] = expf((e0 + e1) + (e2 + e3));
            }
            float k0[32], k1[32];
            float p0 = fexp(run0), p1 = fexp(run1);
#pragma unroll
            for (int i = 31; i >= 0; --i) { const float fi = fexp(c0[i]); k0[i] = (1.f - fi) * p0; p0 *= fi; }
#pragma unroll
            for (int i = 0; i < 32; ++i) { const float fi = fexp(c1[i]); k1[i] = (1.f - fi) * p1; p1 *= fi; }
            char* kt0 = shm + HL_K + d * HROW + seg * 64;
            char* kt1 = shm + P1_K1 + d * HROW + seg * 64;
#pragma unroll
            for (int i = 0; i < 32; i += 8) {
                *(bf16x8*)(kt0 + i * 2) = pack8(k0[i], k0[i + 1], k0[i + 2], k0[i + 3], k0[i + 4], k0[i + 5], k0[i + 6], k0[i + 7]);
                *(bf16x8*)(kt1 + i * 2) = pack8(k1[i], k1[i + 1], k1[i + 2], k1[i + 3], k1[i + 4], k1[i + 5], k1[i + 6], k1[i + 7]);
            }
        }
        __syncthreads();
        {
            const int dir = wave >> 2, vblk = wave & 3;
            const char* kbase = shm + (dir ? P1_K1 : HL_K);
            f32x16 L[4];
#pragma unroll
            for (int j = 0; j < 4; ++j)
#pragma unroll
                for (int i = 0; i < 16; ++i) L[j][i] = 0.f;
#pragma unroll
            for (int ks = 0; ks < 8; ++ks) {
                const bf16x8 af = *(const bf16x8*)(shm + HL_VT + (vblk * 32 + r) * HROW + (ks * 16 + hh * 8) * 2);
#pragma unroll
                for (int j = 0; j < 4; ++j) {
                    const bf16x8 bf = *(const bf16x8*)(kbase + (j * 32 + r) * HROW + (ks * 16 + hh * 8) * 2);
                    L[j] = MFMA32(af, bf, L[j]);
                }
            }
            const int sidx = ((dir * 4 + b) * 4 + h) * 64 + m;
            bf16_t* sp = states + (size_t)sidx * 16384;
#pragma unroll
            for (int j = 0; j < 4; ++j)
#pragma unroll
                for (int i = 0; i < 16; ++i) sp[(vblk * 32 + crow(i, hh)) * 128 + j * 32 + r] = f2bf(L[j][i]);
        }
    }
}

DI void phase_hgrn_scan(bf16_t* states, const float* __restrict__ dec) {
    const int gt = obid() * NTHREADS + otid();
    for (int u = gt; u < 32 * 4096; u += ogdim() * NTHREADS) {
        const int chain = u >> 12, e4 = u & 4095, dir = chain >> 4;
        const int d0 = (e4 * 4) & 127;
        bf16_t* sp = states + (size_t)chain * 64 * 16384 + e4 * 4;
        const float* dp = dec + (size_t)chain * 64 * 128 + d0;
        float c0 = 0.f, c1 = 0.f, c2 = 0.f, c3 = 0.f;
#pragma unroll 1
        for (int mb = 0; mb < 64; mb += 16) {
            u32x2 w[16]; f32x4 dv[16];
#pragma unroll
            for (int k = 0; k < 16; ++k) { const int m = dir ? 63 - (mb + k) : mb + k; w[k] = *(const u32x2*)(sp + (size_t)m * 16384); dv[k] = *(const f32x4*)(dp + m * 128); }
#pragma unroll
            for (int k = 0; k < 16; ++k) {
                const int m = dir ? 63 - (mb + k) : mb + k;
                u32x2 o; o.x = pk2(c0, c1); o.y = pk2(c2, c3);
                *(u32x2*)(sp + (size_t)m * 16384) = o;
                c0 = dv[k].x * c0 + bflo(w[k].x); c1 = dv[k].y * c1 + bfhi(w[k].x); c2 = dv[k].z * c2 + bflo(w[k].y); c3 = dv[k].w * c3 + bfhi(w[k].y);
            }
        }
    }
}

constexpr int H3_QH = 0, H3_KC = 34816, H3_KHT = 69632, H3_VT = 104448, H3_GDEC = 139264, H3_SSQ = 141312;
#define MFMA16(a, b, c) __builtin_amdgcn_mfma_f32_16x16x32_bf16((a), (b), (c), 0, 0, 0)
DI bf16x8 ld2x8(const char* p, int second_off) { const u32x2 lo = *(const u32x2*)p, hi = *(const u32x2*)(p + second_off); u32x4 w; w.x = lo.x; w.y = lo.y; w.z = hi.x; w.w = hi.y; return __builtin_bit_cast(bf16x8, w); }

DI void hgrn3_stage(const bf16_t* proj, const float* lb, int dir, int b, int h, int m, char* shm, const float (&qv)[32]) {
    const int tid = otid(), d = tid & 127, seg = tid >> 7;
    const bf16_t* zp = proj + pidx(4 + dir, b, h, m * 128 + seg * 32) + d;
    float f[32], ec[32];
#pragma unroll
    for (int i = 0; i < 32; ++i) f[i] = fexp(bf2f(zp[i * 128]));
    if (dir == 0) {
        ec[0] = f[0];
#pragma unroll
        for (int i = 1; i < 32; ++i) ec[i] = ec[i - 1] * f[i];
    } else {
        ec[31] = f[31];
#pragma unroll
        for (int i = 30; i >= 0; --i) ec[i] = ec[i + 1] * f[i];
    }
    ((float*)(shm + H3_GDEC))[seg * 128 + d] = dir == 0 ? ec[31] : ec[0];
    bf16_t* qh = (bf16_t*)(shm + H3_QH); bf16_t* kc = (bf16_t*)(shm + H3_KC);
#pragma unroll
    for (int i = 0; i < 32; ++i) {
        const int t = seg * 32 + i;
        qh[t * 136 + d] = f2bf(qv[i] * ec[i]);
        kc[t * 136 + d] = f2bf((1.f - f[i]) * fminf(__builtin_amdgcn_rcpf(ec[i]), 1e30f));
    }
    float rem = 1.f;
    if (dir == 0) {
#pragma unroll
        for (int i = 31; i >= 0; --i) { const float fi = f[i]; ec[i] = (1.f - fi) * rem; rem *= fi; }
    } else {
#pragma unroll
        for (int i = 0; i < 32; ++i) { const float fi = f[i]; ec[i] = (1.f - fi) * rem; rem *= fi; }
    }
    char* kt = shm + H3_KHT + d * HROW + seg * 64;
#pragma unroll
    for (int i = 0; i < 32; i += 8)
        *(bf16x8*)(kt + i * 2) = pack8(ec[i], ec[i + 1], ec[i + 2], ec[i + 3], ec[i + 4], ec[i + 5], ec[i + 6], ec[i + 7]);
}

template <int DIR>
DI void hgrn3_mma(const char* shm, f32x4 (&S)[8], f32x4 (&O)[4][2], int v0, int j, int q4) {
#pragma unroll
    for (int step = 0; step < 4; ++step) {
        const int I = DIR == 0 ? step : 3 - step;
        {
            bf16x8 sb[4];
#pragma unroll
            for (int a = 0; a < 4; ++a) sb[a] = pack8(S[2 * a][0], S[2 * a][1], S[2 * a][2], S[2 * a][3], S[2 * a + 1][0], S[2 * a + 1][1], S[2 * a + 1][2], S[2 * a + 1][3]);
#pragma unroll
            for (int tt = 0; tt < 2; ++tt)
#pragma unroll
                for (int a = 0; a < 4; ++a) {
                    const bf16x8 af = ld2x8(shm + H3_QH + (32 * I + 16 * tt + j) * HROW + (32 * a + 4 * q4) * 2, 32);
                    O[I][tt] = MFMA16(af, sb[a], O[I][tt]);
                }
        }
        {
            f32x4 XT[2][2];
#pragma unroll
            for (int st = 0; st < 2; ++st)
#pragma unroll
                for (int tt = 0; tt < 2; ++tt) XT[st][tt] = (f32x4){0.f, 0.f, 0.f, 0.f};
#pragma unroll
            for (int ks = 0; ks < 4; ++ks) {
                bf16x8 kf[2], qf[2];
#pragma unroll
                for (int st = 0; st < 2; ++st) kf[st] = *(const bf16x8*)(shm + H3_KC + (32 * I + 16 * st + j) * HROW + (32 * ks + 8 * q4) * 2);
#pragma unroll
                for (int tt = 0; tt < 2; ++tt) qf[tt] = *(const bf16x8*)(shm + H3_QH + (32 * I + 16 * tt + j) * HROW + (32 * ks + 8 * q4) * 2);
#pragma unroll
                for (int st = 0; st < 2; ++st)
#pragma unroll
                    for (int tt = 0; tt < 2; ++tt) XT[st][tt] = MFMA16(kf[st], qf[tt], XT[st][tt]);
            }
#pragma unroll
            for (int st = 0; st < 2; ++st)
#pragma unroll
                for (int tt = 0; tt < 2; ++tt)
#pragma unroll
                    for (int rg = 0; rg < 4; ++rg) {
                        const int s = 16 * st + 4 * q4 + rg, t = 16 * tt + j;
                        const bool keep = DIR == 0 ? (s <= t) : (s >= t);
                        XT[st][tt][rg] = keep ? XT[st][tt][rg] : 0.f;
                    }
            const bf16x8 vf = ld2x8(shm + H3_VT + (v0 + j) * HROW + (32 * I + 4 * q4) * 2, 32);
#pragma unroll
            for (int tt = 0; tt < 2; ++tt) {
                const bf16x8 pa = pack8(XT[0][tt][0], XT[0][tt][1], XT[0][tt][2], XT[0][tt][3], XT[1][tt][0], XT[1][tt][1], XT[1][tt][2], XT[1][tt][3]);
                O[I][tt] = MFMA16(pa, vf, O[I][tt]);
            }
        }
        {
            const float* gd = (const float*)(shm + H3_GDEC) + I * 128 + 4 * q4;
            const bf16x8 vb = *(const bf16x8*)(shm + H3_VT + (v0 + j) * HROW + (32 * I + 8 * q4) * 2);
#pragma unroll
            for (int dt = 0; dt < 8; ++dt) {
                const f32x4 g4 = *(const f32x4*)(gd + 16 * dt);
                S[dt] = S[dt] * g4;
                const bf16x8 ka = *(const bf16x8*)(shm + H3_KHT + (16 * dt + j) * HROW + (32 * I + 8 * q4) * 2);
                S[dt] = MFMA16(ka, vb, S[dt]);
            }
        }
    }
}

DI void phase_hgrn_pass3(const bf16_t* __restrict__ proj, const float* __restrict__ lb, const bf16_t* __restrict__ states, bf16_t* __restrict__ y, const float* __restrict__ hog) {
    extern __shared__ __attribute__((aligned(16))) char shm[];
#pragma unroll 1
    for (int item = obid(); item < NB * 4 * 64; item += ogdim()) {
        const int tid = otid(), wave = __builtin_amdgcn_readfirstlane(tid >> 6), lane = tid & 63, j = lane & 15, q4 = lane >> 4;
        const int b = item >> 8, h = (item >> 6) & 3, m = item & 63;
        const size_t tok0 = (size_t)b * S_ + m * 128;
        const int v0 = wave * 16;
        __syncthreads();
        {
            const int s = tid & 127, vg = tid >> 7;
            const bf16_t* ip = proj + pidx(6, b, h, m * 128 + s) + vg * 32;
            bf16_t* vtl = (bf16_t*)(shm + H3_VT);
#pragma unroll
            for (int jj = 0; jj < 4; ++jj) {
                const u32x4 w = *(const u32x4*)(ip + jj * 8);
                const unsigned ww[4] = {w.x, w.y, w.z, w.w};
#pragma unroll
                for (int e = 0; e < 4; ++e) {
                    const int v = vg * 32 + jj * 8 + e * 2;
                    vtl[v * 136 + s] = (bf16_t)(ww[e] & 0xffffu);
                    vtl[(v + 1) * 136 + s] = (bf16_t)(ww[e] >> 16);
                }
            }
        }
        float qv[32];
        {
            const int d = tid & 127, seg = tid >> 7;
            const bf16_t* qp = proj + pidx(3, b, h, m * 128 + seg * 32) + d;
#pragma unroll
            for (int i = 0; i < 32; ++i) qv[i] = bf2f(qp[i * 128]);
        }
        f32x4 O[4][2];
#pragma unroll
        for (int I = 0; I < 4; ++I)
#pragma unroll
            for (int tt = 0; tt < 2; ++tt) O[I][tt] = (f32x4){0.f, 0.f, 0.f, 0.f};
#pragma unroll 1
        for (int dir = 0; dir < 2; ++dir) {
            hgrn3_stage(proj, lb, dir, b, h, m, shm, qv);
            const int sidx = ((dir * 4 + b) * 4 + h) * 64 + m;
            const bf16_t* sp = states + (size_t)sidx * 16384 + (v0 + j) * 128 + 4 * q4;
            f32x4 S[8];
#pragma unroll
            for (int dt = 0; dt < 8; ++dt) { const u32x2 w = *(const u32x2*)(sp + 16 * dt); S[dt] = (f32x4){bflo(w.x), bfhi(w.x), bflo(w.y), bfhi(w.y)}; }
            __syncthreads();
            if (dir == 0) hgrn3_mma<0>(shm, S, O, v0, j, q4); else hgrn3_mma<1>(shm, S, O, v0, j, q4);
            __syncthreads();
        }
        float* ssq = (float*)(shm + H3_SSQ);
#pragma unroll
        for (int I = 0; I < 4; ++I)
#pragma unroll
            for (int tt = 0; tt < 2; ++tt)
#pragma unroll
                for (int rg = 0; rg < 4; ++rg) {
                    float ss = O[I][tt][rg] * O[I][tt][rg];
                    ss += dpp_ror<8>(ss); ss += dpp_ror<4>(ss); ss += dpp_ror<2>(ss); ss += dpp_ror<1>(ss);
                    if (j == 0) ssq[wave * 128 + 32 * I + 16 * tt + 4 * q4 + rg] = ss;
                }
        __syncthreads();
        if (tid < 128) { float s = 0.f;
#pragma unroll
            for (int w = 0; w < 8; ++w) s += ssq[w * 128 + tid];
            ((float*)(shm + H3_GDEC))[tid] = 1.0f / sqrtf(s * (1.f / 128.f) + EPS); }
        __syncthreads();
        const float* rstdv = (const float*)(shm + H3_GDEC);
        const float og = hog[v0 + j];
        bf16_t gl[4][2][4];
#pragma unroll
        for (int I = 0; I < 4; ++I)
#pragma unroll
            for (int tt = 0; tt < 2; ++tt)
#pragma unroll
                for (int rg = 0; rg < 4; ++rg) gl[I][tt][rg] = proj[pidx(7, b, h, m * 128 + 32 * I + 16 * tt + 4 * q4 + rg) + v0 + j];
#pragma unroll
        for (int I = 0; I < 4; ++I)
#pragma unroll
            for (int tt = 0; tt < 2; ++tt)
#pragma unroll
                for (int rg = 0; rg < 4; ++rg) {
                    const int tl = 32 * I + 16 * tt + 4 * q4 + rg;
                    const size_t tok = tok0 + tl;
                    const float g = bf2f(gl[I][tt][rg]);
                    const float sg = g * __builtin_amdgcn_rcpf(1.f + fexp(-g));
                    y[tok * D_ + 512 + h * 128 + v0 + j] = f2bf(O[I][tt][rg] * rstdv[tl] * og * sg);
                }
    }
}

DI void phase_glu(const bf16_t* __restrict__ u, bf16_t* __restrict__ act, const float* __restrict__ cw, const float* __restrict__ cb) {
    const int gt = obid() * NTHREADS + otid();
    constexpr int NCG = DFF / 8, NSTRIP = 16384 / 32;
    for (int unit = gt; unit < NSTRIP * NCG; unit += ogdim() * NTHREADS) {
        const int strip = unit / NCG, cgp = unit % NCG, j0 = cgp * 8, r0 = strip * 32;
        float w[2][3][8], bb[2][8];
#pragma unroll
        for (int hf = 0; hf < 2; ++hf) {
#pragma unroll
            for (int k = 0; k < 3; ++k) {
                const f32x4 a = *(const f32x4*)(cw + (size_t)k * DUP + hf * DFF + j0), c = *(const f32x4*)(cw + (size_t)k * DUP + hf * DFF + j0 + 4);
                w[hf][k][0] = a.x; w[hf][k][1] = a.y; w[hf][k][2] = a.z; w[hf][k][3] = a.w; w[hf][k][4] = c.x; w[hf][k][5] = c.y; w[hf][k][6] = c.z; w[hf][k][7] = c.w;
            }
            const f32x4 a = *(const f32x4*)(cb + hf * DFF + j0), c = *(const f32x4*)(cb + hf * DFF + j0 + 4);
            bb[hf][0] = a.x; bb[hf][1] = a.y; bb[hf][2] = a.z; bb[hf][3] = a.w; bb[hf][4] = c.x; bb[hf][5] = c.y; bb[hf][6] = c.z; bb[hf][7] = c.w;
        }
        u32x4 pa, pv, ca, cv, na, nv;
        const u32x4 zero = {0u, 0u, 0u, 0u};
        const bool first = (r0 & 8191) == 0;
        pa = first ? zero : *(const u32x4*)(u + (size_t)(r0 - 1) * DUP + j0);
        pv = first ? zero : *(const u32x4*)(u + (size_t)(r0 - 1) * DUP + DFF + j0);
        ca = *(const u32x4*)(u + (size_t)r0 * DUP + j0);
        cv = *(const u32x4*)(u + (size_t)r0 * DUP + DFF + j0);
#pragma unroll 4
        for (int i = 0; i < 32; ++i) {
            const int rr = r0 + i;
            const bool last = (rr & 8191) == 8191;
            na = last ? zero : *(const u32x4*)(u + (size_t)(rr + 1) * DUP + j0);
            nv = last ? zero : *(const u32x4*)(u + (size_t)(rr + 1) * DUP + DFF + j0);
            const unsigned pA[4] = {pa.x, pa.y, pa.z, pa.w}, cA[4] = {ca.x, ca.y, ca.z, ca.w}, nA[4] = {na.x, na.y, na.z, na.w};
            const unsigned pV[4] = {pv.x, pv.y, pv.z, pv.w}, cV[4] = {cv.x, cv.y, cv.z, cv.w}, nV[4] = {nv.x, nv.y, nv.z, nv.w};
            float res[8];
#pragma unroll
            for (int e = 0; e < 4; ++e) {
                const float a0 = w[0][0][2 * e] * bflo(pA[e]) + w[0][1][2 * e] * bflo(cA[e]) + w[0][2][2 * e] * bflo(nA[e]) + bb[0][2 * e];
                const float a1 = w[0][0][2 * e + 1] * bfhi(pA[e]) + w[0][1][2 * e + 1] * bfhi(cA[e]) + w[0][2][2 * e + 1] * bfhi(nA[e]) + bb[0][2 * e + 1];
                const float v0 = w[1][0][2 * e] * bflo(pV[e]) + w[1][1][2 * e] * bflo(cV[e]) + w[1][2][2 * e] * bflo(nV[e]) + bb[1][2 * e];
                const float v1 = w[1][0][2 * e + 1] * bfhi(pV[e]) + w[1][1][2 * e + 1] * bfhi(cV[e]) + w[1][2][2 * e + 1] * bfhi(nV[e]) + bb[1][2 * e + 1];
                res[2 * e] = a0 / (1.f + expf(-a0)) * v0; res[2 * e + 1] = a1 / (1.f + expf(-a1)) * v1;
            }
            u32x4 o; o.x = pk2(res[0], res[1]); o.y = pk2(res[2], res[3]); o.z = pk2(res[4], res[5]); o.w = pk2(res[6], res[7]);
            *(u32x4*)(act + (size_t)rr * DFF + j0) = o;
            pa = ca; pv = cv; ca = na; cv = nv;
        }
    }
}

#define XB_TMO      128
#define XB_XCNT(j)  (256  + 64 * (j))
#define XB_XSUB(j)  (1280 + 64 * (j))
#define XB_XGEN(j)  (2304 + 64 * (j))
#define XB_TOP      3328
#define XB_TOPGEN   3392
#define XCD_BAR_WORDS 3456
#define XB_SPIN_CAP (1u << 22)
DI unsigned xb_ld(unsigned* p) { return __hip_atomic_load(p, __ATOMIC_RELAXED, __HIP_MEMORY_SCOPE_AGENT); }
DI unsigned xb_add(unsigned* p, unsigned v) { return __hip_atomic_fetch_add(p, v, __ATOMIC_RELAXED, __HIP_MEMORY_SCOPE_AGENT); }
DI unsigned xb_xcc_id() { return (unsigned)__builtin_amdgcn_s_getreg((3 << 11) | 20) & 0xFu; }
#define XB_SPIN(cond, bar) do { unsigned _sp = 0; while (cond) { __builtin_amdgcn_s_sleep(1); \
    if ((++_sp & 255u) == 0u) { if (xb_ld(&(bar)[XB_TMO])) break; if (_sp > XB_SPIN_CAP) { atomicAdd(&(bar)[XB_TMO], 1u); break; } } } } while (0)
struct XcdBarrier { unsigned* bar; unsigned x; volatile unsigned* st; };
DI XcdBarrier xcd_barrier_post(unsigned* bar, volatile unsigned* st) {
    XcdBarrier b; b.bar = bar; b.x = xb_xcc_id(); b.st = st;
    if (threadIdx.x == 0) (void)xb_add(&bar[XB_XCNT(b.x)], 1u);
    return b;
}
DI void xcd_barrier_complete(unsigned* bar, unsigned x, unsigned& nloc, unsigned& nx) {
    const unsigned G = gridDim.x;
    unsigned sum, cnt, mine, sp = 0u;
    for (;;) {
        sum = 0u; cnt = 0u; mine = 0u;
#pragma unroll 1
        for (unsigned j = 0; j < 16; ++j) { const unsigned c = xb_ld(&bar[XB_XCNT(j)]); sum += c; cnt += (c > 0u) ? 1u : 0u; mine = (j == x) ? c : mine; }
        if (sum == G) break;
        __builtin_amdgcn_s_sleep(1);
        if ((++sp & 255u) == 0u) { if (xb_ld(&bar[XB_TMO])) break; if (sp > XB_SPIN_CAP) { atomicAdd(&bar[XB_TMO], 1u); break; } }
    }
    nloc = mine > 0u ? mine : 1u; nx = cnt > 0u ? cnt : 1u;
}
DI void xcd_barrier(const XcdBarrier& b) {
    asm volatile("s_waitcnt vmcnt(0)" ::: "memory");
    __syncthreads();
    if (threadIdx.x == 0) {
        unsigned* bar = b.bar;
        __builtin_amdgcn_s_waitcnt(0);
        const unsigned nloc = b.st[0], nx = b.st[1];
        const unsigned old = xb_add(&bar[XB_XSUB(b.x)], 1u);
        const unsigned gen = old / nloc;
        if (old + 1u == (gen + 1u) * nloc) {
            __builtin_amdgcn_fence(__ATOMIC_RELEASE, "agent");
            asm volatile("s_waitcnt vmcnt(0)" ::: "memory");
            const unsigned og = xb_add(&bar[XB_TOP], 1u);
            const unsigned tg = og / nx;
            if (og + 1u == (tg + 1u) * nx) xb_add(&bar[XB_TOPGEN], 1u);
            else XB_SPIN(xb_ld(&bar[XB_TOPGEN]) == tg, bar);
            __builtin_amdgcn_fence(__ATOMIC_ACQUIRE, "agent");
            xb_add(&bar[XB_XGEN(b.x)], 1u);
            asm volatile("s_waitcnt vmcnt(0)" ::: "memory");
        } else {
            XB_SPIN(xb_ld(&bar[XB_XGEN(b.x)]) == gen, bar);
            __builtin_amdgcn_fence(__ATOMIC_ACQUIRE, "agent");
            asm volatile("s_waitcnt vmcnt(0)" ::: "memory");
        }
    }
    __syncthreads();
}

enum { PH_PROLOGUE = 0, PH_NORM1, PH_INPROJ, PH_PREP, PH_SCAN, PH_MIX, PH_OUTPROJ, PH_NORM2, PH_UP, PH_GLU, PH_DOWN };

template <int PH>
DI void run_phase(const Params& p, int l, int hf) {
    extern __shared__ __attribute__((aligned(16))) char shm[];
    unsigned char* ws = p.ws;
    bf16_t* hbuf = (bf16_t*)(ws + OFF_H);
    bf16_t* states = (bf16_t*)(ws + OFF_H);
    float* dec = (float*)(ws + OFF_DEC);
    bf16_t* vt = (bf16_t*)(ws + OFF_VT);
    bf16_t* proj = (bf16_t*)(ws + OFF_PROJ);
    bf16_t* ybuf = (bf16_t*)(ws + OFF_Y);
    bf16_t* halo = (bf16_t*)(ws + OFF_HALO);
    bf16_t* actbuf = (bf16_t*)(ws + OFF_ACT);
    const float* rope = (const float*)(ws + OFF_ROPE);
    const float* misc = (const float*)(ws + OFF_MISC);
    const float* xin = l == 0 ? p.x : p.out;
    if (PH == PH_PROLOGUE) { phase_prologue(p, shm); phase_rmsnorm(p.x, p.mix_g, hbuf); }
    if (PH == PH_NORM1) phase_rmsnorm(xin, p.mix_g + l * D_, hbuf);
    if (PH == PH_INPROJ) { EpiArgs ea; ea.ob = proj; ea.ldo = DIN; ea.vt = vt; ea.resid = nullptr; ea.of = nullptr; ea.lb = misc + l * 1024; ea.cw = nullptr; ea.cb = nullptr; ea.halo = nullptr; ea.ssqp = nullptr; ea.cnt = nullptr; ea.gn = nullptr; ea.hn = nullptr;
        gemm_phase<EPI_PROJ>(hbuf, (const bf16_t*)(ws + OFF_WIN) + (size_t)l * 4096 * 1024, T_, DIN, D_, ea); }
    if (PH == PH_PREP) { phase_qkprep(proj, rope, p.kg + l * 64); phase_hgrn_pass1(proj, misc + l * 1024, states, dec); }
    if (PH == PH_SCAN) phase_hgrn_scan(states, dec);
    if (PH == PH_MIX) {
        const float lamv = __int_as_float(__builtin_amdgcn_readfirstlane(__float_as_int(misc[2048 + l])));
        const float oscv = __int_as_float(__builtin_amdgcn_readfirstlane(__float_as_int(misc[2052 + l])));
        const float mbv = __int_as_float(__builtin_amdgcn_readfirstlane(__float_as_int(misc[2050 + l])));
        if (mbv > 60.f) phase_attention<true>(proj, vt, ybuf, p.dog + l * 128, lamv, oscv, mbv, rope, p.qg + l * 64);
        else phase_attention<false>(proj, vt, ybuf, p.dog + l * 128, lamv, oscv, 0.f, rope, p.qg + l * 64);
        phase_hgrn_pass3(proj, misc + l * 1024, states, ybuf, p.hog + l * 128);
    }
    if (PH == PH_OUTPROJ) { EpiArgs ea; ea.ob = nullptr; ea.ldo = 0; ea.vt = nullptr; ea.resid = xin; ea.of = p.out; ea.lb = nullptr; ea.cw = nullptr; ea.cb = nullptr; ea.halo = nullptr;
        ea.hn = hbuf; ea.gn = p.ffn_g + l * D_; ea.ssqp = (float*)(ws + OFF_SSQ) + (size_t)(2 * l) * T_ * 16; ea.cnt = (unsigned*)(ws + OFF_BAR) + CNT_WORD + (2 * l) * 128;
        gemm_phase<EPI_RESIDN>(ybuf, (const bf16_t*)(ws + OFF_WOUT) + (size_t)l * 1024 * 1024, T_, D_, D_, ea); }
    if (PH == PH_NORM2) phase_rmsnorm(p.out, p.ffn_g + l * D_, hbuf);
    if (PH == PH_UP) { EpiArgs ea; ea.ob = actbuf; ea.ldo = DFF; ea.vt = nullptr; ea.resid = nullptr; ea.of = nullptr; ea.lb = nullptr;
        ea.cw = p.conv_w + (size_t)l * 3 * DUP; ea.cb = p.conv_b + (size_t)l * DUP; ea.halo = halo; ea.ssqp = nullptr; ea.cnt = nullptr; ea.gn = nullptr; ea.hn = nullptr;
        gemm_phase<EPI_GLU>(hbuf, (const bf16_t*)(ws + OFF_WUP) + (size_t)l * 5632 * 1024, T_, DUP, D_, ea); }
    if (PH == PH_GLU) phase_glu_fixup(halo, actbuf, p.conv_w + (size_t)l * 3 * DUP, p.conv_b + (size_t)l * DUP);
    if (PH == PH_DOWN) { EpiArgs ea; ea.ob = nullptr; ea.ldo = 0; ea.vt = nullptr; ea.resid = p.out; ea.of = p.out; ea.lb = nullptr; ea.cw = nullptr; ea.cb = nullptr; ea.halo = nullptr;
        ea.hn = nullptr; ea.gn = nullptr; ea.ssqp = nullptr; ea.cnt = nullptr;
        if (l == 0) { ea.hn = hbuf; ea.gn = p.mix_g + D_; ea.ssqp = (float*)(ws + OFF_SSQ) + (size_t)1 * T_ * 16; ea.cnt = (unsigned*)(ws + OFF_BAR) + CNT_WORD + 128;
            gemm_phase<EPI_RESIDN>(actbuf, (const bf16_t*)(ws + OFF_WDN), T_, D_, DFF, ea); }
        else gemm_phase<EPI_RESID>(actbuf, (const bf16_t*)(ws + OFF_WDN) + (size_t)l * 1024 * 2816, T_, D_, DFF, ea); }
}

#ifndef FUSED
#define FUSED 1
#endif

#if FUSED
__global__ void __launch_bounds__(NTHREADS) fwd_megakernel(Params p) {
    extern __shared__ __attribute__((aligned(16))) char shm[];
    cg::grid_group grid = cg::this_grid();
    volatile unsigned* st = (volatile unsigned*)(shm + LDS_MAIN);
    if (threadIdx.x == 0) { st[0] = 0u; st[1] = 0u; }
    __syncthreads();
    const XcdBarrier xb = xcd_barrier_post((unsigned*)(p.ws + OFF_BAR), st);
    run_phase<PH_PROLOGUE>(p, 0, 0); grid.sync();
    if (threadIdx.x == 0) { unsigned nloc, nx; xcd_barrier_complete(xb.bar, xb.x, nloc, nx); st[0] = nloc; st[1] = nx; }
    __syncthreads();
#pragma unroll 1
    for (int l = 0; l < 2; ++l) {
        run_phase<PH_INPROJ>(p, l, 0); xcd_barrier(xb);
        run_phase<PH_PREP>(p, l, 0); xcd_barrier(xb);
        run_phase<PH_SCAN>(p, l, 0); xcd_barrier(xb);
        run_phase<PH_MIX>(p, l, 0); xcd_barrier(xb);
        run_phase<PH_OUTPROJ>(p, l, 0); xcd_barrier(xb);
        run_phase<PH_UP>(p, l, 0); xcd_barrier(xb);
        run_phase<PH_GLU>(p, l, 0); xcd_barrier(xb);
        run_phase<PH_DOWN>(p, l, 0); xcd_barrier(xb);
    }
}
#else
template <int PH>
__global__ void __launch_bounds__(NTHREADS) k_phase(Params p, int l, int hf) { run_phase<PH>(p, l, hf); }
#endif

template <int PH>
static void launch_phase(const Params& p, int l, int hf, int grid, hipStream_t stream) {
#if !FUSED
    static bool attr_set = false;
    if (!attr_set) { (void)hipFuncSetAttribute((const void*)k_phase<PH>, hipFuncAttributeMaxDynamicSharedMemorySize, LDS_BYTES); attr_set = true; }
    hipLaunchKernelGGL(k_phase<PH>, dim3(grid), dim3(NTHREADS), LDS_BYTES, stream, p, l, hf);
#endif
}

extern "C" void kernel_launch(void* const* d_in, const int* in_sizes, int n_in, void* d_out, int out_size, void* d_ws, size_t ws_size, hipStream_t stream) {
    static int grid_blocks = 0;
    if (grid_blocks == 0) {
        if (n_in != 19 || ws_size < WS_END) { fprintf(stderr, "kernel_launch: unexpected n_in %d or ws_size %zu (< %zu)\n", n_in, ws_size, (size_t)WS_END); grid_blocks = -1; return; }
        int dev = 0, cus = 0, per_cu = 1;
        (void)hipGetDevice(&dev);
        (void)hipDeviceGetAttribute(&cus, hipDeviceAttributeMultiprocessorCount, dev);
#if FUSED
        (void)hipFuncSetAttribute((const void*)fwd_megakernel, hipFuncAttributeMaxDynamicSharedMemorySize, LDS_BYTES);
        (void)hipOccupancyMaxActiveBlocksPerMultiprocessor(&per_cu, (const void*)fwd_megakernel, NTHREADS, LDS_BYTES);
        if (per_cu < 1) per_cu = 1;
#endif
        grid_blocks = cus * per_cu;
        (void)hipGetLastError();
    }
    if (grid_blocks < 0) return;
    Params p{};
    p.x = (const float*)d_in[0]; p.pos = (const int*)d_in[1]; p.mix_g = (const float*)d_in[2]; p.w_in = (const float*)d_in[3];
    p.qg = (const float*)d_in[4]; p.kg = (const float*)d_in[5]; p.lq1 = (const float*)d_in[6]; p.lk1 = (const float*)d_in[7];
    p.lq2 = (const float*)d_in[8]; p.lk2 = (const float*)d_in[9]; p.dog = (const float*)d_in[10]; p.lbl = (const float*)d_in[11];
    p.hog = (const float*)d_in[12]; p.w_out = (const float*)d_in[13]; p.ffn_g = (const float*)d_in[14]; p.w_up = (const float*)d_in[15];
    p.conv_w = (const float*)d_in[16]; p.conv_b = (const float*)d_in[17]; p.w_down = (const float*)d_in[18];
    p.out = (float*)d_out; p.ws = (unsigned char*)d_ws;
#if FUSED
    (void)hipMemsetAsync((char*)d_ws + OFF_BAR, 0, 16384, stream);
    void* args[] = {&p};
    hipError_t e = hipLaunchCooperativeKernel((const void*)fwd_megakernel, dim3(grid_blocks), dim3(NTHREADS), args, LDS_BYTES, stream);
    if (e != hipSuccess) fprintf(stderr, "cooperative launch failed: %s (grid %d)\n", hipGetErrorString(e), grid_blocks);
#else
    const int g = grid_blocks;
    launch_phase<PH_PROLOGUE>(p, 0, 0, g, stream);
    for (int l = 0; l < 2; ++l) {
        launch_phase<PH_NORM1>(p, l, 0, g, stream);
        launch_phase<PH_INPROJ>(p, l, 0, g, stream);
        launch_phase<PH_PREP>(p, l, 0, g, stream);
        launch_phase<PH_SCAN>(p, l, 0, g, stream);
        launch_phase<PH_MIX>(p, l, 0, g, stream);
        launch_phase<PH_OUTPROJ>(p, l, 0, g, stream);
        launch_phase<PH_NORM2>(p, l, 0, g, stream);
        for (int hf = 0; hf < 2; ++hf) {
            launch_phase<PH_UP>(p, l, hf, g, stream);
            launch_phase<PH_GLU>(p, l, hf, g, stream);
            launch_phase<PH_DOWN>(p, l, hf, g, stream);
        }
    }
#endif
}
```
